# Optimizing an MI355X kernel written in HIP

```python
import jax
import jax.numpy as jnp
from jax import lax
import numpy as np

D_MODEL = 1024
BATCH = 16
SEQ = 2048
DEPTH = 2

D_MIX = D_MODEL
N_GROUPS = 4
GROUP_WIDTH = D_MIX // N_GROUPS
A_HEADS = 4
A_DK = GROUP_WIDTH // A_HEADS
A_DV = GROUP_WIDTH // A_HEADS
A_CHUNK = 16
LB_FLOOR = 1e-30
B_HEADS = 4
B_Q_LORA = 256
B_KV_LORA = 128
B_NOPE = 64
B_ROPE = 32
B_V = GROUP_WIDTH // B_HEADS
ROPE_THETA = 10000.0
C_HEADS = 4
C_HEAD_DIM = GROUP_WIDTH // C_HEADS
FOX_GATE_BIAS = 3.0
D_GROUPS = 4
D_GROUP_DIM = GROUP_WIDTH // D_GROUPS
D_CHUNK = 128
Q_BLOCK = 128
D_FF = 2816
N_MOD = 9
ALPHA = (2 * DEPTH) ** 0.25
BETA = (8 * DEPTH) ** -0.25
LN_EPS = 1e-5
RMS_EPS = 1e-6
MIX_SPLIT_SIZES = (GROUP_WIDTH, GROUP_WIDTH, GROUP_WIDTH, GROUP_WIDTH,
                   B_Q_LORA, B_KV_LORA, B_ROPE,
                   GROUP_WIDTH, GROUP_WIDTH, GROUP_WIDTH, C_HEADS,
                   GROUP_WIDTH, GROUP_WIDTH)
MIX_IN_COLS = sum(MIX_SPLIT_SIZES)

kernel_name = "hybrid_hgrn2_mla_fox_gmlp_deepnorm_block"


def layer_norm(x, g, b):
    xf = x.astype(jnp.float32)
    mu = jnp.mean(xf, axis=-1, keepdims=True)
    var = jnp.mean(jnp.square(xf - mu), axis=-1, keepdims=True)
    return ((xf - mu) * lax.rsqrt(var + LN_EPS)).astype(x.dtype) * g + b


def rms_norm(x, g):
    xf = x.astype(jnp.float32)
    return (xf * lax.rsqrt(jnp.mean(xf * xf, axis=-1, keepdims=True) + RMS_EPS)).astype(x.dtype) * g


def swiglu_ffn(h, w_in, w_out):
    gate, up = jnp.split(h @ w_in, 2, axis=-1)
    return (jax.nn.silu(gate) * up) @ w_out


def rope(x, pos):
    half = x.shape[-1] // 2
    inv_freq = ROPE_THETA ** (-jnp.arange(half, dtype=jnp.float32) / half)
    ang = pos.astype(jnp.float32)[:, None] * inv_freq[None, :]
    cos = jnp.cos(ang)[None, :, None, :].astype(x.dtype)
    sin = jnp.sin(ang)[None, :, None, :].astype(x.dtype)
    x1, x2 = x[..., :half], x[..., half:]
    return jnp.concatenate([x1 * cos - x2 * sin, x1 * sin + x2 * cos], axis=-1)


def causal_softmax_attention(q, k, v, cum_log_f=None):
    b, s, h, dk = q.shape
    dv = v.shape[-1]
    n_blocks = s // Q_BLOCK
    scale = dk ** -0.5
    k_pos = jnp.arange(s)
    cum_t = None if cum_log_f is None else jnp.swapaxes(cum_log_f, 1, 2)

    def one_block(i):
        start = i * Q_BLOCK
        q_i = lax.dynamic_slice_in_dim(q, start, Q_BLOCK, axis=1)
        logits = jnp.einsum('bqhd,bkhd->bhqk', q_i, k,
                            preferred_element_type=jnp.float32) * scale
        if cum_t is not None:
            f_i = lax.dynamic_slice_in_dim(cum_t, start, Q_BLOCK, axis=2)
            logits = logits + (f_i[..., :, None] - cum_t[..., None, :])
        q_pos = start + jnp.arange(Q_BLOCK)
        logits = jnp.where(k_pos[None, :] <= q_pos[:, None], logits, -jnp.inf)
        p = jax.nn.softmax(logits, axis=-1).astype(v.dtype)
        return jnp.einsum('bhqk,bkhd->bqhd', p, v)

    out = lax.map(one_block, jnp.arange(n_blocks))
    return jnp.moveaxis(out, 0, 1).reshape(b, s, h * dv)


def hgrn2_mixer(q, f_logit, inp, g_out, lb, norm_g):
    b, s, _ = q.shape
    dt = q.dtype
    n_chunks = s // A_CHUNK
    lbf = lb.astype(jnp.float32)
    log_f = jnp.logaddexp(jnp.log(jnp.maximum(lbf, LB_FLOOR)),
                          jnp.log1p(-lbf) + jax.nn.log_sigmoid(f_logit.astype(jnp.float32)))
    k = -jnp.expm1(log_f)
    qf = jax.nn.silu(q.astype(jnp.float32))
    shp_k = (b, n_chunks, A_CHUNK, A_HEADS, A_DK)
    qf, k, log_f = qf.reshape(shp_k), k.reshape(shp_k), log_f.reshape(shp_k)
    v = inp.astype(jnp.float32).reshape(b, n_chunks, A_CHUNK, A_HEADS, A_DV)
    G = jnp.cumsum(log_f, axis=2)
    G_last = G[:, :, -1:]
    causal = jnp.tril(jnp.ones((A_CHUNK, A_CHUNK), dtype=bool))[None, None, :, :, None, None]
    rel = jnp.where(causal, G[:, :, :, None] - G[:, :, None, :], -jnp.inf)
    decay = jnp.exp(rel)
    scores = jnp.einsum('bctha,bcsha,bctsha->bchts', qf, k, decay)
    o_intra = jnp.einsum('bchts,bcshv->bcthv', scores, v)
    q_dec = qf * jnp.exp(G)
    k_to_end = k * jnp.exp(G_last - G)
    chunk_kv = jnp.einsum('bcsha,bcshv->cbhav', k_to_end, v)
    chunk_decay = jnp.transpose(jnp.exp(G_last[:, :, 0]), (1, 0, 2, 3))

    def step(state, xs):
        dec, kv = xs
        return dec[..., None] * state + kv, state

    state0 = jnp.zeros((b, A_HEADS, A_DK, A_DV), jnp.float32)
    _, state_in = lax.scan(step, state0, (chunk_decay, chunk_kv))
    o_inter = jnp.einsum('bctha,cbhav->bcthv', q_dec, state_in)
    o = (o_intra + o_inter).reshape(b, s, A_HEADS, A_DV)
    o = rms_norm(o, norm_g.astype(jnp.float32).reshape(A_HEADS, A_DV)).reshape(b, s, GROUP_WIDTH)
    return (o * jax.nn.silu(g_out.astype(jnp.float32))).astype(dt)


def mla_mixer(c_q, c_kv, k_rope, q_norm_g, kv_norm_g, w_uq, w_ukv, pos):
    b, s, _ = c_q.shape
    q = (rms_norm(c_q, q_norm_g) @ w_uq).reshape(b, s, B_HEADS, B_NOPE + B_ROPE)
    q_nope, q_rope = q[..., :B_NOPE], q[..., B_NOPE:]
    kv = (rms_norm(c_kv, kv_norm_g) @ w_ukv).reshape(b, s, B_HEADS, B_NOPE + B_V)
    k_nope, v = kv[..., :B_NOPE], kv[..., B_NOPE:]
    k_r = rope(k_rope[:, :, None, :], pos)
    q = jnp.concatenate([q_nope, rope(q_rope, pos)], axis=-1)
    k = jnp.concatenate([k_nope, jnp.broadcast_to(k_r, (b, s, B_HEADS, B_ROPE))], axis=-1)
    return causal_softmax_attention(q, k, v)


def fox_mixer(q, k, v, f_logit, b_f):
    b, s, _ = q.shape
    shp = (b, s, C_HEADS, C_HEAD_DIM)
    log_f = jax.nn.log_sigmoid(f_logit.astype(jnp.float32) + b_f.astype(jnp.float32))
    cum = jnp.cumsum(log_f, axis=1)
    return causal_softmax_attention(q.reshape(shp), k.reshape(shp), v.reshape(shp), cum)


def gmlp_mixer(u, v, ln_g, ln_b, w_s, b_s):
    b, s, _ = u.shape
    n_chunks = s // D_CHUNK
    u = jax.nn.gelu(u)
    v = layer_norm(jax.nn.gelu(v), ln_g, ln_b).reshape(b, n_chunks, D_CHUNK, D_GROUPS, D_GROUP_DIM)
    causal = jnp.tril(jnp.ones((D_CHUNK, D_CHUNK), dtype=bool))
    w = jnp.where(causal, w_s, 0.0)
    mixed = jnp.einsum('gts,bcsgd->bctgd', w, v) + jnp.swapaxes(b_s, 0, 1)[:, :, None]
    return u * mixed.reshape(b, s, GROUP_WIDTH)


def hybrid_token_mixer(h, w_in, w_out, lb, hgrn_norm_g, mla_q_norm_g, mla_kv_norm_g,
                       mla_w_uq, mla_w_ukv, fox_b_f, gmlp_ln_g, gmlp_ln_b, gmlp_w_s, gmlp_b_s):
    split_idx = [int(i) for i in np.cumsum(MIX_SPLIT_SIZES)[:-1]]
    proj = h @ w_in
    (a_q, a_f, a_i, a_g, b_cq, b_ckv, b_kr,
     c_q, c_k, c_v, c_f, d_u, d_v) = jnp.split(proj, split_idx, axis=-1)
    pos = jnp.arange(h.shape[1])
    o_a = hgrn2_mixer(a_q, a_f, a_i, a_g, lb, hgrn_norm_g)
    o_b = mla_mixer(b_cq, b_ckv, b_kr, mla_q_norm_g, mla_kv_norm_g, mla_w_uq, mla_w_ukv, pos)
    o_c = fox_mixer(c_q, c_k, c_v, c_f, fox_b_f)
    o_d = gmlp_mixer(d_u, d_v, gmlp_ln_g, gmlp_ln_b, gmlp_w_s, gmlp_b_s)
    return jnp.concatenate([o_a, o_b.astype(h.dtype), o_c.astype(h.dtype), o_d], axis=-1) @ w_out


def setup_inputs(seed: int = 0) -> dict:
    key = jax.random.key(seed)
    ks = jax.random.split(key, 23)
    L = DEPTH

    def nrm(k, shape, scale):
        return scale * jax.random.normal(k, shape, jnp.float32)

    return {
        'x': nrm(ks[0], (BATCH, SEQ, D_MODEL), 1.0),
        'c': nrm(ks[1], (BATCH, D_MODEL), 1.0),
        'ada_w': nrm(ks[2], (L, D_MODEL, N_MOD * D_MODEL), 0.1 * D_MODEL ** -0.5),
        'ada_b': nrm(ks[3], (L, N_MOD * D_MODEL), 0.01),
        'ln_g': 1.0 + nrm(ks[4], (L, 3, D_MODEL), 0.02),
        'ln_b': nrm(ks[5], (L, 3, D_MODEL), 0.02),
        'ffn1_w_in': nrm(ks[6], (L, D_MODEL, 2 * D_FF), D_MODEL ** -0.5),
        'ffn1_w_out': nrm(ks[7], (L, D_FF, D_MODEL), BETA * D_FF ** -0.5),
        'ffn2_w_in': nrm(ks[8], (L, D_MODEL, 2 * D_FF), D_MODEL ** -0.5),
        'ffn2_w_out': nrm(ks[9], (L, D_FF, D_MODEL), BETA * D_FF ** -0.5),
        'mix_w_in': nrm(ks[10], (L, D_MODEL, MIX_IN_COLS), D_MODEL ** -0.5),
        'mix_w_out': nrm(ks[11], (L, D_MIX, D_MODEL), BETA * D_MIX ** -0.5),
        'hgrn_lb_logits': nrm(ks[12], (L, GROUP_WIDTH), 0.5),
        'hgrn_norm_g': 1.0 + nrm(ks[13], (L, GROUP_WIDTH), 0.02),
        'mla_q_norm_g': 1.0 + nrm(ks[14], (L, B_Q_LORA), 0.02),
        'mla_kv_norm_g': 1.0 + nrm(ks[15], (L, B_KV_LORA), 0.02),
        'mla_w_uq': nrm(ks[16], (L, B_Q_LORA, B_HEADS * (B_NOPE + B_ROPE)), B_Q_LORA ** -0.5),
        'mla_w_ukv': nrm(ks[17], (L, B_KV_LORA, B_HEADS * (B_NOPE + B_V)), B_KV_LORA ** -0.5),
        'fox_b_f': FOX_GATE_BIAS + nrm(ks[18], (L, C_HEADS), 0.5),
        'gmlp_ln_g': 1.0 + nrm(ks[19], (L, GROUP_WIDTH), 0.02),
        'gmlp_ln_b': nrm(ks[20], (L, GROUP_WIDTH), 0.02),
        'gmlp_w_s': nrm(ks[21], (L, D_GROUPS, D_CHUNK, D_CHUNK), 0.5 * D_CHUNK ** -0.5),
        'gmlp_b_s': 1.0 + nrm(ks[22], (L, D_GROUPS, D_CHUNK), 0.02),
    }


def reference(x, c, ada_w, ada_b, ln_g, ln_b, ffn1_w_in, ffn1_w_out, ffn2_w_in, ffn2_w_out,
              mix_w_in, mix_w_out, hgrn_lb_logits, hgrn_norm_g, mla_q_norm_g, mla_kv_norm_g,
              mla_w_uq, mla_w_ukv, fox_b_f, gmlp_ln_g, gmlp_ln_b, gmlp_w_s, gmlp_b_s):
    lb_sm = jax.nn.softmax(hgrn_lb_logits.astype(jnp.float32), axis=0)
    lb_all = jnp.cumsum(lb_sm, axis=0) - lb_sm[0]
    c_act = jax.nn.silu(c)
    for l in range(DEPTH):
        mod = (c_act @ ada_w[l] + ada_b[l])[:, None, :]
        sh1, sc1, g1, sh2, sc2, g2, sh3, sc3, g3 = jnp.split(mod, N_MOD, axis=-1)
        h = x * (1.0 + sc1) + sh1
        x = layer_norm(ALPHA * x + 0.5 * (1.0 + g1) * swiglu_ffn(h, ffn1_w_in[l], ffn1_w_out[l]),
                       ln_g[l, 0], ln_b[l, 0])
        h = x * (1.0 + sc2) + sh2
        mixed = hybrid_token_mixer(h, mix_w_in[l], mix_w_out[l], lb_all[l], hgrn_norm_g[l],
                                   mla_q_norm_g[l], mla_kv_norm_g[l], mla_w_uq[l], mla_w_ukv[l],
                                   fox_b_f[l], gmlp_ln_g[l], gmlp_ln_b[l], gmlp_w_s[l], gmlp_b_s[l])
        x = layer_norm(ALPHA * x + (1.0 + g2) * mixed, ln_g[l, 1], ln_b[l, 1])
        h = x * (1.0 + sc3) + sh3
        x = layer_norm(ALPHA * x + 0.5 * (1.0 + g3) * swiglu_ffn(h, ffn2_w_in[l], ffn2_w_out[l]),
                       ln_g[l, 2], ln_b[l, 2])
    return x
```

```cpp
#include <hip/hip_runtime.h>
#include <hip/hip_cooperative_groups.h>
#include <cstdio>
#include <cstdint>
#include <cmath>
__device__ __forceinline__ int tid_l() { int t = threadIdx.x; asm volatile("" : "+v"(t)); return t; }
__device__ __forceinline__ int bid_l() { int t = blockIdx.x; asm volatile("" : "+s"(t)); return t; }
__device__ __forceinline__ int opaque_i(int v) { asm volatile("" : "+s"(v)); return v; }
__device__ __forceinline__ int gdim_l() { int t = gridDim.x; asm volatile("" : "+s"(t)); return t; }
namespace pg8 {
#define PG8_LAS __attribute__((address_space(3)))
typedef unsigned short bf16_t;
typedef short bf16x8 __attribute__((ext_vector_type(8)));
typedef float f32x4 __attribute__((ext_vector_type(4)));
typedef unsigned u32x4 __attribute__((ext_vector_type(4)));
constexpr int BM = 256, BK = 64, HALF = 128, HTB = HALF * BK * 2  , STAGE_BYTES = 8 * HTB, NXCD = 8, WGM = 8;

__host__ __device__ __forceinline__ int lds_byte(int r, int c) { const int st = (r >> 4) * 2 + (c >> 5), rr = r & 15, cc = c & 31, ob = rr * 64 + cc * 2; return st * 1024 + (ob ^ (((ob >> 9) & 1) << 5)); }
__host__ __device__ __forceinline__ void stage_rc(int b, int& R, int& C) { const int st = b / 1024, sb = b % 1024, swz = sb ^ (((sb >> 9) & 1) << 5); R = (st >> 1) * 16 + swz / 64; C = (st & 1) * 32 + (swz % 64) / 2; }
__host__ __device__ __forceinline__ int perm32(int rho) { const int n = rho >> 4, i = rho & 15; return 8 * (i >> 2) + 4 * n + (i & 3); }

struct Unit { int pm, pn; };
struct Gemm { const bf16_t* A; const bf16_t* Bt; int M, N, K; };

struct StaticOrder {
    int nM, nN, nwg, G, c;
    __host__ __device__ void init(int M, int N, int G_, int c_) { nM = M / BM; nN = N / BM; nwg = nM * nN; G = G_; c = c_; }
    __host__ __device__ bool next(int i, Unit& u) const {
        const long L = (long)i * G + c; if (L >= nwg) return false;
        int wgid = (int)L; { const int q = nwg / NXCD, r = nwg % NXCD, xcd = wgid % NXCD, off = wgid / NXCD; wgid = (xcd < r ? xcd * (q + 1) : r * (q + 1) + (xcd - r) * q) + off; }
        const int nig = WGM * nN, gid = wgid / nig, fm = gid * WGM, gsz = (nM - fm) < WGM ? (nM - fm) : WGM;
        u.pm = fm + ((wgid % nig) % gsz); u.pn = (wgid % nig) / gsz; return true;
    }
    __device__ __forceinline__ void a_ready(const Unit&) const {}
    __device__ __forceinline__ void done(const Unit&) const {}
};

__device__ __forceinline__ unsigned cvt_pk_bf16(float lo, float hi) { unsigned r; asm volatile("v_cvt_pk_bf16_f32 %0, %1, %2" : "=v"(r) : "v"(lo), "v"(hi)); return r; }
typedef float f32x2 __attribute__((ext_vector_type(2)));
__device__ __forceinline__ f32x2 gelu_pk(f32x2 v) {
    const f32x2 av = __builtin_elementwise_abs(v), d = av * 0.2316418882f + 1.0f;
    f32x2 t; t.x = __builtin_amdgcn_rcpf(d.x); t.y = __builtin_amdgcn_rcpf(d.y);
    f32x2 q = t * 0.5307027145f + (-0.7265760135f); q = q * t + 0.7107068705f; q = q * t + (-0.142248368f); q = q * t + 0.127414796f; q = q * t;
    const f32x2 s = (v * v) * (-0.72134752044f);
    f32x2 e; e.x = __builtin_amdgcn_exp2f(s.x); e.y = __builtin_amdgcn_exp2f(s.y);
    const f32x2 m = v * (q * e), r = v - m;
    f32x2 o; o.x = v.x < 0.f ? m.x : r.x; o.y = v.y < 0.f ? m.y : r.y; return o;
}

template <int ACT  > struct EpiBf16 {
    static constexpr bool PERM = true, AFTER_DRAIN = false; static_assert(ACT == 0 || ACT == 1, "EpiBf16: ACT is 0 (none) or 1 (gelu_pk)");
    bf16_t* O; int ldc; const float* bias; int split_cols; size_t split_stride; float scale0;
    __device__ __forceinline__ void operator()(const f32x4 (&acc)[2][2][4][2], const Unit& u, int wr, int wc, int fr, int fq) const {
        const int row0 = u.pm * BM + wr * 64 + fr; int colt = u.pn * BM; bf16_t* base = O;
        float sc = 1.f; if (split_cols) { const int t = colt / split_cols; base += (size_t)t * split_stride; colt -= t * split_cols; if (t == 0) sc = scale0; }
        const int col0 = colt + wc * 32 + 8 * fq, bcol0 = u.pn * BM + wc * 32 + 8 * fq;
        f32x4 bv[2][2];
#pragma unroll
        for (int bj = 0; bj < 2; ++bj)
#pragma unroll
            for (int n = 0; n < 2; ++n) bv[bj][n] = bias ? *(const f32x4*)(bias + bcol0 + bj * HALF + 4 * n) : (f32x4){0.f, 0.f, 0.f, 0.f};
#pragma unroll
        for (int ai = 0; ai < 2; ++ai)
#pragma unroll
            for (int m = 0; m < 4; ++m) { bf16_t* rowp = base + (size_t)(row0 + ai * HALF + m * 16) * ldc + col0;
#pragma unroll
                for (int bj = 0; bj < 2; ++bj) { f32x4 v0 = acc[ai][bj][m][0] + bv[bj][0], v1 = acc[ai][bj][m][1] + bv[bj][1];
                    if (ACT == 1) { f32x2 a = gelu_pk((f32x2){v0[0], v0[1]}), b = gelu_pk((f32x2){v0[2], v0[3]}), c = gelu_pk((f32x2){v1[0], v1[1]}), d = gelu_pk((f32x2){v1[2], v1[3]});
                        v0 = (f32x4){a.x, a.y, b.x, b.y}; v1 = (f32x4){c.x, c.y, d.x, d.y}; }
                    v0 = v0 * sc; v1 = v1 * sc; u32x4 w; w.x = cvt_pk_bf16(v0[0], v0[1]); w.y = cvt_pk_bf16(v0[2], v0[3]); w.z = cvt_pk_bf16(v1[0], v1[1]); w.w = cvt_pk_bf16(v1[2], v1[3]);
                    *(u32x4*)(rowp + bj * HALF) = w; } }
    }
};
__device__ __forceinline__ float silu_f(float x) { return x * __builtin_amdgcn_rcpf(1.0f + __expf(-x)); }
struct EpiSwiGLU {
    static constexpr bool PERM = true, AFTER_DRAIN = false;
    bf16_t* O; int ldc;
    __device__ __forceinline__ void operator()(const f32x4 (&acc)[2][2][4][2], const Unit& u, int wr, int wc, int fr, int fq) const {
        const int row0 = u.pm * BM + wr * 64 + fr, col0 = u.pn * HALF + wc * 32 + 8 * fq;
#pragma unroll
        for (int ai = 0; ai < 2; ++ai)
#pragma unroll
            for (int m = 0; m < 4; ++m) { bf16_t* rowp = O + (size_t)(row0 + ai * HALF + m * 16) * ldc + col0;
                const f32x4 g0 = acc[ai][0][m][0], g1 = acc[ai][0][m][1], u0 = acc[ai][1][m][0], u1 = acc[ai][1][m][1];
                u32x4 w; w.x = cvt_pk_bf16(silu_f(g0[0]) * u0[0], silu_f(g0[1]) * u0[1]); w.y = cvt_pk_bf16(silu_f(g0[2]) * u0[2], silu_f(g0[3]) * u0[3]);
                w.z = cvt_pk_bf16(silu_f(g1[0]) * u1[0], silu_f(g1[1]) * u1[1]); w.w = cvt_pk_bf16(silu_f(g1[2]) * u1[2], silu_f(g1[3]) * u1[3]);
                *(u32x4*)rowp = w; }
    }
};
struct EpiResid {
    static constexpr bool PERM = false, AFTER_DRAIN = false;
    float* X; const float* gate; float gs, alpha;
    __device__ __forceinline__ void operator()(const f32x4 (&acc)[2][2][4][2], const Unit& u, int wr, int wc, int fr, int fq) const {
        const float* gp = gate + (size_t)(u.pm >> 3) * 9216; const int col0 = u.pn * BM + wc * 32 + 4 * fq;
#pragma unroll
        for (int bj = 0; bj < 2; ++bj)
#pragma unroll
            for (int n = 0; n < 2; ++n) { const int c = col0 + bj * HALF + n * 16; f32x4 gv = *(const f32x4*)(gp + c); gv = (gv + 1.0f) * gs;
#pragma unroll
                for (int ai = 0; ai < 2; ++ai)
#pragma unroll
                    for (int m = 0; m < 4; ++m) { float* p = X + (size_t)(u.pm * BM + ai * HALF + wr * 64 + m * 16 + fr) * 1024 + c;
                        const f32x4 xv = *(const f32x4*)p; *(f32x4*)p = xv * alpha + gv * acc[ai][bj][m][n]; } }
    }
};
struct EpiQup {
    static constexpr bool PERM = true, AFTER_DRAIN = false;
    bf16_t* Q; float qs;
    __device__ __forceinline__ void operator()(const f32x4 (&acc)[2][2][4][2], const Unit& u, int wr, int wc, int fr, int fq) const {
#pragma unroll
        for (int bj = 0; bj < 2; ++bj) {
            if (u.pn * 2 + bj >= 3) continue;
            const int col0 = u.pn * BM + bj * HALF + wc * 32 + 8 * fq;
#pragma unroll
            for (int ai = 0; ai < 2; ++ai)
#pragma unroll
                for (int m = 0; m < 4; ++m) { const size_t row = (size_t)(u.pm * BM + ai * HALF + wr * 64 + m * 16 + fr);
                    const f32x4 v0 = acc[ai][bj][m][0] * qs, v1 = acc[ai][bj][m][1] * qs;
                    u32x4 w; w.x = cvt_pk_bf16(v0[0], v0[1]); w.y = cvt_pk_bf16(v0[2], v0[3]); w.z = cvt_pk_bf16(v1[0], v1[1]); w.w = cvt_pk_bf16(v1[2], v1[3]);
                    *(u32x4*)(Q + row * 384 + col0) = w; }
        }
    }
};
struct EpiKVup {
    static constexpr bool PERM = true, AFTER_DRAIN = false;
    bf16_t* Kb; bf16_t* Vb;
    __device__ __forceinline__ void operator()(const f32x4 (&acc)[2][2][4][2], const Unit& u, int wr, int wc, int fr, int fq) const {
#pragma unroll
        for (int bj = 0; bj < 2; ++bj) { const int h = 2 * u.pn + bj, dd = wc * 32 + 8 * fq;
#pragma unroll
            for (int ai = 0; ai < 2; ++ai)
#pragma unroll
                for (int m = 0; m < 4; ++m) { const size_t row = (size_t)(u.pm * BM + ai * HALF + wr * 64 + m * 16 + fr);
                    const f32x4 v0 = acc[ai][bj][m][0], v1 = acc[ai][bj][m][1];
                    u32x4 w; w.x = cvt_pk_bf16(v0[0], v0[1]); w.y = cvt_pk_bf16(v0[2], v0[3]); w.z = cvt_pk_bf16(v1[0], v1[1]); w.w = cvt_pk_bf16(v1[2], v1[3]);
                    bf16_t* p = (dd < 64) ? (Kb + row * 384 + 96 * h + dd) : (Vb + row * 256 + 64 * h + (dd - 64));
                    *(u32x4*)p = w; } }
    }
};
template <class Epi, class Sched, bool ALIGN_EPI = false, bool SP2 = false>
__device__ __forceinline__ void gemm_phase(PG8_LAS unsigned char* lds, const Gemm g, const Sched& S, const Epi& E) {
    const int tid = tid_l(), wid = __builtin_amdgcn_readfirstlane(tid >> 6), lane = tid & 63, wr = wid >> 2, wc = wid & 3, fr = lane & 15, fq = lane >> 4;
    const int K = g.K, nt = K / BK;
    unsigned voffA[2], voffB[2];
#pragma unroll
    for (int i = 0; i < 2; ++i) { int R, C; stage_rc(tid * 16 + i * 8192, R, C); const int Rb = Epi::PERM ? ((R & ~31) + perm32(R & 31)) : R;
        voffA[i] = (unsigned)(R * K + C) * 2u; voffB[i] = (unsigned)(Rb * K + C) * 2u; }
    const size_t kstep = (size_t)(BK * 2);
    const size_t hstep = (size_t)HALF * K * 2;
    const size_t tstep = 2 * hstep;
    const unsigned ldsw = (unsigned)wid * 1024u;
    const int aoff = lds_byte(wr * 64 + fr, fq * 8), boff = lds_byte(wc * 32 + fr, fq * 8);
#define PG8_SA(b, h) (((b) * 2 + (h)) * HTB)
#define PG8_SB(b, h) ((4 + (b) * 2 + (h)) * HTB)
#define PG8_STAGE(bufoff, gbase, voff) do { _Pragma("unroll") for (int _i = 0; _i < 2; ++_i) \
        __builtin_amdgcn_global_load_lds((const unsigned*)((const char*)(gbase) + (voff)[_i]), (PG8_LAS unsigned*)(lds + (bufoff) + ldsw + _i * 8192), 16, 0, 0); } while (0)
#define PG8_LDA(dst, b, h) do { _Pragma("unroll") for (int m = 0; m < 4; ++m) _Pragma("unroll") for (int k = 0; k < 2; ++k) dst[m][k] = *(const PG8_LAS bf16x8*)(lds + PG8_SA(b, h) + aoff + m * 2048 + k * 1024); } while (0)
#define PG8_LDB(dst, b, h) do { _Pragma("unroll") for (int n = 0; n < 2; ++n) _Pragma("unroll") for (int k = 0; k < 2; ++k) dst[n][k] = *(const PG8_LAS bf16x8*)(lds + PG8_SB(b, h) + boff + n * 2048 + k * 1024); } while (0)
#define PG8_MMA(ai, bj, At, Bt) do { __builtin_amdgcn_s_setprio(1); _Pragma("unroll") for (int m = 0; m < 4; ++m) _Pragma("unroll") for (int n = 0; n < 2; ++n) _Pragma("unroll") for (int k = 0; k < 2; ++k) \
        acc[ai][bj][m][n] = __builtin_amdgcn_mfma_f32_16x16x32_bf16(Bt[n][k], At[m][k], acc[ai][bj][m][n], 0, 0, 0); __builtin_amdgcn_s_setprio(0); } while (0)
#define PG8_WAIT_V(n) asm volatile("s_waitcnt vmcnt(" #n ")" ::: "memory")
#define PG8_WAIT_L(n) asm volatile("s_waitcnt lgkmcnt(" #n ")" ::: "memory")
#define PG8_BAR __builtin_amdgcn_s_barrier()
#define PG8_SCHED __builtin_amdgcn_sched_barrier(0)
    Unit cur, nxt; int ui = 0;
    if (!S.next(0, cur)) return;
    f32x4 acc[2][2][4][2];
#pragma unroll
    for (int a = 0; a < 2; ++a)
#pragma unroll
        for (int b = 0; b < 2; ++b)
#pragma unroll
            for (int m = 0; m < 4; ++m)
#pragma unroll
                for (int n = 0; n < 2; ++n) acc[a][b][m][n] = (f32x4){0.f, 0.f, 0.f, 0.f};
    bf16x8 At[4][2], B0[2][2], B1[2][2];
    const char* cA = (const char*)g.A + (size_t)cur.pm * tstep; const char* cB = (const char*)g.Bt + (size_t)cur.pn * tstep;
    S.a_ready(cur);
    if constexpr (SP2) {
        PG8_STAGE(PG8_SB(0, 0), cB, voffB); PG8_STAGE(PG8_SB(0, 1), cB + hstep, voffB); PG8_STAGE(PG8_SA(0, 0), cA, voffA); PG8_STAGE(PG8_SA(0, 1), cA + hstep, voffA);
        if (wr == 1) PG8_BAR;
        PG8_WAIT_V(2); PG8_BAR;
        PG8_STAGE(PG8_SB(1, 0), cB + kstep, voffB); PG8_STAGE(PG8_SA(1, 0), cA + kstep, voffA); PG8_STAGE(PG8_SB(1, 1), cB + hstep + kstep, voffB);
        PG8_WAIT_V(6); PG8_BAR;
    } else {
        PG8_STAGE(PG8_SB(0, 0), cB, voffB); PG8_STAGE(PG8_SA(0, 0), cA, voffA); PG8_STAGE(PG8_SB(0, 1), cB + hstep, voffB); PG8_STAGE(PG8_SA(0, 1), cA + hstep, voffA);
        if (wr == 1) PG8_BAR;
        PG8_WAIT_V(4); PG8_BAR;
        PG8_STAGE(PG8_SB(1, 0), cB + kstep, voffB); PG8_STAGE(PG8_SA(1, 0), cA + kstep, voffA); PG8_STAGE(PG8_SB(1, 1), cB + hstep + kstep, voffB);
        PG8_WAIT_V(6); PG8_BAR;
    }
    for (;;) {
        const bool has_next = S.next(ui + 1, nxt);
        const char* nA = has_next ? (const char*)g.A + (size_t)nxt.pm * tstep : cA; const char* nB = has_next ? (const char*)g.Bt + (size_t)nxt.pn * tstep : cB;
        for (int t = 0; t < nt; t += 2) {
            const bool last = (t == nt - 2);
            const char* a1 = cA + (size_t)(t + 1) * kstep;
            const char* a2 = last ? nA : cA + (size_t)(t + 2) * kstep; const char* b2 = last ? nB : cB + (size_t)(t + 2) * kstep;
            const char* a3 = a2 + kstep; const char* b3 = b2 + kstep;
            if (last && has_next) S.a_ready(nxt);
            if constexpr (SP2) {
            PG8_LDB(B0, 0, 0); PG8_LDB(B1, 0, 1); PG8_SCHED; PG8_LDA(At, 0, 0); PG8_STAGE(PG8_SA(1, 1), a1 + hstep, voffA);
            PG8_WAIT_V(8); PG8_WAIT_L(0); PG8_BAR; PG8_MMA(0, 0, At, B0); PG8_MMA(0, 1, At, B1); PG8_BAR; PG8_SCHED;
            PG8_LDA(At, 0, 1); PG8_STAGE(PG8_SB(0, 0), b2, voffB); PG8_STAGE(PG8_SB(0, 1), b2 + hstep, voffB); PG8_STAGE(PG8_SA(0, 0), a2, voffA);
            PG8_WAIT_V(8); PG8_WAIT_L(0); PG8_BAR; PG8_MMA(1, 0, At, B0); PG8_MMA(1, 1, At, B1); PG8_BAR; PG8_SCHED;
            PG8_LDB(B0, 1, 0); PG8_LDB(B1, 1, 1); PG8_SCHED; PG8_LDA(At, 1, 0); PG8_STAGE(PG8_SA(0, 1), a2 + hstep, voffA);
            PG8_WAIT_V(8); PG8_WAIT_L(0); PG8_BAR; PG8_MMA(0, 0, At, B0); PG8_MMA(0, 1, At, B1); PG8_BAR; PG8_SCHED;
            PG8_LDA(At, 1, 1); PG8_STAGE(PG8_SB(1, 0), b3, voffB); PG8_STAGE(PG8_SB(1, 1), b3 + hstep, voffB); PG8_STAGE(PG8_SA(1, 0), a3, voffA);
            PG8_WAIT_V(8); PG8_WAIT_L(0); PG8_BAR; PG8_MMA(1, 0, At, B0); PG8_MMA(1, 1, At, B1); PG8_BAR; PG8_SCHED;
            } else {
            PG8_LDB(B0, 0, 0); PG8_SCHED; PG8_LDA(At, 0, 0); PG8_STAGE(PG8_SA(1, 1), a1 + hstep, voffA);
            PG8_WAIT_L(8); PG8_BAR; PG8_WAIT_L(0); PG8_MMA(0, 0, At, B0); PG8_BAR; PG8_SCHED;
            PG8_LDB(B1, 0, 1); PG8_STAGE(PG8_SB(0, 0), b2, voffB);
            PG8_BAR; PG8_WAIT_L(0); PG8_MMA(0, 1, At, B1); PG8_BAR;
            PG8_LDA(At, 0, 1); PG8_STAGE(PG8_SA(0, 0), a2, voffA);
            PG8_BAR; PG8_WAIT_L(0); PG8_MMA(1, 0, At, B0); PG8_BAR; PG8_SCHED;
            PG8_STAGE(PG8_SB(0, 1), b2 + hstep, voffB);
            PG8_WAIT_V(6); PG8_BAR; PG8_MMA(1, 1, At, B1); PG8_BAR;
            PG8_LDB(B0, 1, 0); PG8_SCHED; PG8_LDA(At, 1, 0); PG8_STAGE(PG8_SA(0, 1), a2 + hstep, voffA);
            PG8_WAIT_L(8); PG8_BAR; PG8_WAIT_L(0); PG8_MMA(0, 0, At, B0); PG8_BAR; PG8_SCHED;
            PG8_LDB(B1, 1, 1); PG8_STAGE(PG8_SB(1, 0), b3, voffB);
            PG8_BAR; PG8_WAIT_L(0); PG8_MMA(0, 1, At, B1); PG8_BAR;
            PG8_LDA(At, 1, 1); PG8_STAGE(PG8_SA(1, 0), a3, voffA);
            PG8_BAR; PG8_WAIT_L(0); PG8_MMA(1, 0, At, B0); PG8_BAR; PG8_SCHED;
            PG8_STAGE(PG8_SB(1, 1), b3 + hstep, voffB);
            PG8_WAIT_V(6); PG8_BAR; PG8_MMA(1, 1, At, B1); PG8_BAR;
            }
        }
        if constexpr (ALIGN_EPI) { if (wr == 0) PG8_BAR; }
        if constexpr (!Epi::AFTER_DRAIN) { E(acc, cur, wr, wc, fr, fq); S.done(cur); }
        if (!has_next) break;
#pragma unroll
        for (int a = 0; a < 2; ++a)
#pragma unroll
            for (int b = 0; b < 2; ++b)
#pragma unroll
                for (int m = 0; m < 4; ++m)
#pragma unroll
                    for (int n = 0; n < 2; ++n) acc[a][b][m][n] = (f32x4){0.f, 0.f, 0.f, 0.f};
        cur = nxt; cA = nA; cB = nB; ++ui;
        if constexpr (ALIGN_EPI) { if (wr == 1) PG8_BAR; }
    }
    PG8_WAIT_V(0);
    if constexpr (!ALIGN_EPI) { if (wr == 0) PG8_BAR; }
    PG8_BAR;
    if constexpr (Epi::AFTER_DRAIN) { E.fused(acc, cur, wr, wc, fr, fq, lds, wid, lane); S.done(cur); }
#undef PG8_SA
#undef PG8_SB
#undef PG8_STAGE
#undef PG8_LDA
#undef PG8_LDB
#undef PG8_MMA
#undef PG8_WAIT_V
#undef PG8_WAIT_L
#undef PG8_BAR
#undef PG8_SCHED
}
}

namespace cg = cooperative_groups;
#define LAS __attribute__((address_space(3)))
typedef unsigned short bf16;
typedef float f32x4 __attribute__((ext_vector_type(4)));
typedef float f32x16 __attribute__((ext_vector_type(16)));
typedef short bf16x8 __attribute__((ext_vector_type(8)));
typedef short s16x4 __attribute__((ext_vector_type(4)));
typedef unsigned u32x4 __attribute__((ext_vector_type(4)));
typedef unsigned u32x2 __attribute__((ext_vector_type(2)));

#ifndef MK_PER_PHASE
#define MK_PER_PHASE 0
#endif

constexpr int NB = 16, SEQ = 2048, DM = 1024, MROWS = NB * SEQ, DFF = 2816, NMIX = 2816  , NMOD = 9216;
constexpr float ALPHA_C = 1.4142135623730951f, LN_EPS_C = 1e-5f, RMS_EPS_C = 1e-6f, LOG2E = 1.4426950408889634f;
constexpr int PC_AQ = 0, PC_AF = 256, PC_AI = 512, PC_AG = 768, PC_BCQ = 1024, PC_BCKV = 1280, PC_BKR = 1408, PC_CQ = 1440, PC_CK = 1696, PC_CV = 1952, PC_DU = 2208, PC_DV = 2464, PC_CF = 2720;

constexpr size_t MiB = 1u << 20;
constexpr size_t WS_CTL = 0, WS_MOD = 1 * MiB, WS_ROPE = 3 * MiB, WS_FNEG = 3 * MiB + 512 * 1024;
constexpr size_t WS_WIN = 4 * MiB, WIN_SZ = 11 * MiB;
constexpr size_t WS_WOUT = 48 * MiB, WOUT_SZ = 5 * MiB + 512 * 1024;
constexpr size_t WS_WMIX = 70 * MiB, WMIX_SZ = 5 * MiB + 512 * 1024;
constexpr size_t WS_WMO = 81 * MiB, WMO_SZ = 2 * MiB;
constexpr size_t WS_WUQ = 85 * MiB, WUQ_SZ = 256 * 1024, WS_WUKV = 85 * MiB + 512 * 1024, WUKV_SZ = 128 * 1024;
constexpr size_t WS_H = 86 * MiB, WS_HID = 150 * MiB, WS_CAT = 326 * MiB, WS_QM = 390 * MiB, WS_KM = 414 * MiB, WS_VM = 438 * MiB, WS_CQN = 454 * MiB, WS_CKVN = 470 * MiB, WS_END = 478 * MiB;
constexpr int RING_BYTES = 131072, MISC_OFF = RING_BYTES + 320, LDS_BYTES = 147456;
constexpr int NPHASE = 28;

struct Args {
    const float* in[23]; float* out; unsigned char* ws; int ph_lo, ph_hi;
};
typedef const __attribute__((address_space(4))) Args* ArgsP;
__device__ __forceinline__ ArgsP launder(ArgsP p) { asm volatile("" : "+s"(p)); return p; }

__device__ __forceinline__ float wave_sum(float v) {
#pragma unroll
    for (int o = 1; o < 64; o <<= 1) v += __shfl_xor(v, o);
    return v;
}
__device__ __forceinline__ float bf2f(unsigned short b) { return __uint_as_float((unsigned)b << 16); }
__device__ __forceinline__ float bflo(unsigned u) { return __uint_as_float(u << 16); }
__device__ __forceinline__ float bfhi(unsigned u) { return __uint_as_float(u & 0xffff0000u); }
__device__ __forceinline__ unsigned pk_bf16(float lo, float hi) { return pg8::cvt_pk_bf16(lo, hi); }
__device__ __forceinline__ float silu_x(float x) { return x / (1.0f + __expf(-x)); }
__device__ __forceinline__ float gelu_tanh(float x) { const float y = 0.7978845608028654f * (x + 0.044715f * x * x * x); const float e = __expf(2.0f * y); const float th = 1.0f - 2.0f / (e + 1.0f); return 0.5f * x * (1.0f + th); }
#define LDS_FENCE() asm volatile("s_waitcnt lgkmcnt(0)" ::: "memory")

__device__ __forceinline__ void tr_item(const float* __restrict__ W, int K, int N, int k0, int ns, int nvalid, bf16* WT, int nd, LAS float* scr, int lane) {
    const int nn = lane & 31;
#pragma unroll 8
    for (int i = 0; i < 32; ++i) { const int kk = 2 * i + (lane >> 5); scr[kk * 33 + nn] = (nn < nvalid) ? W[(size_t)(k0 + kk) * N + ns + nn] : 0.f; }
    LDS_FENCE();
    const int c = lane & 7;
#pragma unroll
    for (int j = 0; j < 4; ++j) { const int n = (lane >> 3) + 8 * j; const LAS float* s = scr + (8 * c) * 33 + n;
        u32x4 o; o.x = pk_bf16(s[0 * 33], s[1 * 33]); o.y = pk_bf16(s[2 * 33], s[3 * 33]); o.z = pk_bf16(s[4 * 33], s[5 * 33]); o.w = pk_bf16(s[6 * 33], s[7 * 33]);
        *(u32x4*)(WT + (size_t)(nd + n) * K + k0 + 8 * c) = o; }
    LDS_FENCE();
}

__device__ __forceinline__ void p0_prologue(ArgsP ap, LAS unsigned char* lds) {
    const int tid = tid_l(), lane = tid & 63, wave = __builtin_amdgcn_readfirstlane(tid >> 6);
    unsigned char* ws = ap->ws;
    {
        LAS float* scr = (LAS float*)(lds + wave * 16384);
        const int gw = bid_l() * 8 + wave, NGW = gdim_l() * 8;
        constexpr int I_IN = 16 * 176, I_OUT = 44 * 32, I_MIX = 16 * 88, I_MO = 16 * 32, I_UQ = 4 * 16, I_UKV = 2 * 16;
        constexpr int PER_L = 2 * I_IN + 2 * I_OUT + I_MIX + I_MO + I_UQ + I_UKV;
        for (int it = gw; it < 2 * PER_L; it += NGW) {
            const int l = it / PER_L; int r = it % PER_L;
            if (r < 2 * I_IN) { const int f = r / I_IN; r %= I_IN; const int kb = r / 176, db = r % 176, pn = db >> 3, q = db & 7;
                const float* W = ap->in[f ? 8 : 6] + (size_t)l * 1024 * 5632; const int ns = (q < 4) ? (128 * pn + 32 * q) : (2816 + 128 * pn + 32 * (q - 4));
                tr_item(W, 1024, 5632, 64 * kb, ns, 32, (bf16*)(ws + WS_WIN + (size_t)(f * 2 + l) * WIN_SZ), 32 * db, scr, lane); continue; }
            r -= 2 * I_IN;
            if (r < 2 * I_OUT) { const int f = r / I_OUT; r %= I_OUT; const int kb = r / 32, db = r % 32;
                const float* W = ap->in[f ? 9 : 7] + (size_t)l * 2816 * 1024;
                tr_item(W, 2816, 1024, 64 * kb, 32 * db, 32, (bf16*)(ws + WS_WOUT + (size_t)(f * 2 + l) * WOUT_SZ), 32 * db, scr, lane); continue; }
            r -= 2 * I_OUT;
            if (r < I_MIX) { const int kb = r / 88, db = r % 88; int ns, nv;
                if (db < 69) { ns = 32 * db; nv = 32; } else if (db < 85) { ns = 2212 + 32 * (db - 69); nv = 32; } else if (db == 85) { ns = 2208; nv = 4; } else { ns = 0; nv = 0; }
                const float* W = ap->in[10] + (size_t)l * 1024 * 2724;
                tr_item(W, 1024, 2724, 64 * kb, ns, nv, (bf16*)(ws + WS_WMIX + (size_t)l * WMIX_SZ), 32 * db, scr, lane); continue; }
            r -= I_MIX;
            if (r < I_MO) { const int kb = r / 32, db = r % 32;
                tr_item(ap->in[11] + (size_t)l * 1024 * 1024, 1024, 1024, 64 * kb, 32 * db, 32, (bf16*)(ws + WS_WMO + (size_t)l * WMO_SZ), 32 * db, scr, lane); continue; }
            r -= I_MO;
            if (r < I_UQ) { const int kb = r / 16, db = r % 16;
                tr_item(ap->in[16] + (size_t)l * 256 * 384, 256, 384, 64 * kb, 32 * db, db < 12 ? 32 : 0, (bf16*)(ws + WS_WUQ + (size_t)l * WUQ_SZ), 32 * db, scr, lane); continue; }
            r -= I_UQ;
            { const int kb = r / 16, db = r % 16;
                tr_item(ap->in[17] + (size_t)l * 128 * 512, 128, 512, 64 * kb, 32 * db, 32, (bf16*)(ws + WS_WUKV + (size_t)l * WUKV_SZ), 32 * db, scr, lane); }
        }
    }
    {
        float* rope = (float*)(ws + WS_ROPE);
        for (int i = bid_l() * 512 + tid; i < 2048 * 16; i += gdim_l() * 512) { const int pos = i >> 4, j = i & 15;
            const float invf = exp2f(-(float)j * (13.287712379549449f / 16.0f));
            const float ang = (float)pos * invf;
            const double rev = (double)ang * 0.15915494309189535; const float fr = (float)(rev - floor(rev));
            rope[2 * i] = __builtin_amdgcn_cosf(fr); rope[2 * i + 1] = __builtin_amdgcn_sinf(fr); }
    }
    __syncthreads();
    {
        LAS float* cact = (LAS float*)lds;
        LAS float* red = (LAS float*)(lds + 65536);
        const float* c = ap->in[1];
        for (int i = tid; i < 16 * 1024; i += 512) { const int b = i >> 10, k = i & 1023; cact[k * 16 + b] = silu_x(c[i]); }
        __syncthreads();
        float* mod = (float*)(ws + WS_MOD);
        for (int u = bid_l(); u < 2 * 144; u += gdim_l()) {
            const int l = u / 144, n = (u % 144) * 64 + lane;
            const float* wp = ap->in[2] + (size_t)l * 1024 * NMOD + (size_t)(wave * 128) * NMOD + n;
            float acc[16];
#pragma unroll
            for (int b = 0; b < 16; ++b) acc[b] = 0.f;
#pragma unroll 4
            for (int k = 0; k < 128; ++k) { const float wv = wp[(size_t)k * NMOD]; const LAS f32x4* cp = (const LAS f32x4*)(cact + (wave * 128 + k) * 16);
#pragma unroll
                for (int q = 0; q < 4; ++q) { const f32x4 cv = cp[q]; acc[4 * q] += cv[0] * wv; acc[4 * q + 1] += cv[1] * wv; acc[4 * q + 2] += cv[2] * wv; acc[4 * q + 3] += cv[3] * wv; } }
#pragma unroll
            for (int b = 0; b < 16; ++b) red[(wave * 16 + b) * 64 + lane] = acc[b];
            __syncthreads();
            for (int o = tid; o < 16 * 64; o += 512) { const int b = o >> 6, ln = o & 63; float s = 0.f;
#pragma unroll
                for (int w = 0; w < 8; ++w) s += red[(w * 16 + b) * 64 + ln];
                const int nn = (u % 144) * 64 + ln; mod[((size_t)l * 16 + b) * NMOD + nn] = s + ap->in[3][(size_t)l * NMOD + nn]; }
            __syncthreads();
        }
    }
}

__device__ __forceinline__ void ln_phase(const float* xin, float* X, bf16* H, const float* g, const float* bta, const float* sh, const float* sc, bool do_ln) {
    const int tid = tid_l(), lane = tid & 63, wave = tid >> 6;
    const int gw = bid_l() * 8 + wave, NGW = gdim_l() * 8;
    for (int row = gw; row < MROWS; row += NGW) {
        const f32x4* xr = (const f32x4*)((do_ln ? X : xin) + (size_t)row * DM) + lane;
        f32x4 v[4];
#pragma unroll
        for (int j = 0; j < 4; ++j) v[j] = xr[64 * j];
        if (do_ln) {
            float s = 0.f;
#pragma unroll
            for (int j = 0; j < 4; ++j) s += (v[j][0] + v[j][1]) + (v[j][2] + v[j][3]);
            const float mean = wave_sum(s) * (1.f / DM); float s2 = 0.f;
#pragma unroll
            for (int j = 0; j < 4; ++j) { v[j] = v[j] - mean; s2 += (v[j][0] * v[j][0] + v[j][1] * v[j][1]) + (v[j][2] * v[j][2] + v[j][3] * v[j][3]); }
            const float rstd = 1.f / sqrtf(wave_sum(s2) * (1.f / DM) + LN_EPS_C);
#pragma unroll
            for (int j = 0; j < 4; ++j) { const f32x4 gv = ((const f32x4*)g)[lane + 64 * j], bv = ((const f32x4*)bta)[lane + 64 * j]; v[j] = v[j] * rstd * gv + bv; }
        }
        f32x4* xo = (f32x4*)(X + (size_t)row * DM) + lane;
#pragma unroll
        for (int j = 0; j < 4; ++j) xo[64 * j] = v[j];
        if (H) {
            const int b = row >> 11; const f32x4* shp = (const f32x4*)(sh + (size_t)b * NMOD) + lane; const f32x4* scp = (const f32x4*)(sc + (size_t)b * NMOD) + lane;
            u32x2* ho = (u32x2*)(H + (size_t)row * DM) + lane;
#pragma unroll
            for (int j = 0; j < 4; ++j) { const f32x4 hv = v[j] * (scp[64 * j] + 1.0f) + shp[64 * j]; u32x2 w; w.x = pk_bf16(hv[0], hv[1]); w.y = pk_bf16(hv[2], hv[3]); ho[64 * j] = w; }
        }
    }
}

__device__ __forceinline__ void prep_phase(const bf16* PROJ, bf16* CQN, bf16* CKVN, bf16* KM, float* FNEG, const float* rope, const float* qg, const float* kvg, const float* fox_b) {
    const int tid = tid_l(), lane = tid & 63, wave = tid >> 6;
    const int gw = bid_l() * 8 + wave, NGW = gdim_l() * 8;
    if (gw < 64) {
        const int b = gw >> 2, h = gw & 3; const float bf_ = fox_b[h]; float carry = 0.f;
        for (int i = 0; i < 32; ++i) { const int s = 64 * i + lane; const size_t row = (size_t)b * SEQ + s;
            const float z = bf2f(PROJ[row * NMIX + PC_CF + h]) + bf_;
            float v = fminf(z, 0.f) - log1pf(__expf(-fabsf(z)));
#pragma unroll
            for (int o = 1; o < 64; o <<= 1) { const float t = __shfl_up(v, o); if (lane >= o) v += t; }
            v += carry; carry = __shfl(v, 63);
            FNEG[row * 4 + h] = -LOG2E * v; }
    }
    for (int row = gw; row < MROWS; row += NGW) {
        const bf16* p = PROJ + (size_t)row * NMIX;
        {
            const u32x2 u = *(const u32x2*)(p + PC_BCQ + 4 * lane); const float a0 = bflo(u.x), a1 = bfhi(u.x), a2 = bflo(u.y), a3 = bfhi(u.y);
            const float r = 1.f / sqrtf(wave_sum(a0 * a0 + a1 * a1 + a2 * a2 + a3 * a3) * (1.f / 256) + RMS_EPS_C); const f32x4 gv = ((const f32x4*)qg)[lane];
            u32x2 w; w.x = pk_bf16(a0 * r * gv[0], a1 * r * gv[1]); w.y = pk_bf16(a2 * r * gv[2], a3 * r * gv[3]); *(u32x2*)(CQN + (size_t)row * 256 + 4 * lane) = w; }
        {
            const unsigned u = *(const unsigned*)(p + PC_BCKV + 2 * lane); const float a0 = bflo(u), a1 = bfhi(u);
            const float r = 1.f / sqrtf(wave_sum(a0 * a0 + a1 * a1) * (1.f / 128) + RMS_EPS_C);
            *(unsigned*)(CKVN + (size_t)row * 128 + 2 * lane) = pk_bf16(a0 * r * kvg[2 * lane], a1 * r * kvg[2 * lane + 1]); }
        {
            const int j = lane & 15, h = lane >> 4; const float x1 = bf2f(p[PC_BKR + j]), x2 = bf2f(p[PC_BKR + 16 + j]);
            const float c = rope[((size_t)(row & 2047) * 16 + j) * 2], s = rope[((size_t)(row & 2047) * 16 + j) * 2 + 1];
            bf16* kp = KM + (size_t)row * 384 + 96 * h + 64 + j;
            kp[0] = (bf16)(pk_bf16(x1 * c - x2 * s, 0.f) & 0xffffu); kp[16] = (bf16)(pk_bf16(x1 * s + x2 * c, 0.f) & 0xffffu); }
    }
}

constexpr int AT_KCH = 1040, AT_KOFF = 0, AT_VOFF = 12544, AT_BOFF = AT_VOFF + 8192, AT_WOFF = AT_BOFF + 256;
__device__ __forceinline__ s16x4 vtr(const LAS unsigned char* p) { typedef short v4i16_t __attribute__((ext_vector_type(4))); return __builtin_bit_cast(s16x4, __builtin_amdgcn_ds_read_tr16_b64_v4i16((LAS v4i16_t*)p)); }
__device__ __forceinline__ int crow(int r, int hi) { return (r & 3) + 8 * (r >> 2) + 4 * hi; }
template <int DK, bool BIAS, bool ROPE>
__device__ __forceinline__ void attn_unit(LAS unsigned char* lds, const bf16* Qp, int ldq, const bf16* Kp, int ldk, const bf16* Vp, int ldv, const float* biasp, const float* rope, float sc, bf16* Op, int b, int qb) {
    constexpr int NC = DK / 8, NCH = 64 * NC;
    const int tid = tid_l(), lane = tid & 63, w = __builtin_amdgcn_readfirstlane(tid >> 6), r32 = lane & 31, hi = lane >> 5;
    const size_t rowbase = (size_t)b * SEQ; const int q0 = 256 * qb + 32 * w;
    bf16x8 qf[DK / 16];
    { const bf16* qrow = Qp + (rowbase + q0 + r32) * ldq + 8 * hi;
#pragma unroll
      for (int d0 = 0; d0 < DK / 16; ++d0) qf[d0] = *(const bf16x8*)(qrow + 16 * d0); }
    if (ROPE) {
        const f32x4* rp = (const f32x4*)(rope + ((size_t)(q0 + r32) * 16 + 8 * hi) * 2);
        bf16x8 a = qf[DK / 16 - 2], c = qf[DK / 16 - 1];
#pragma unroll
        for (int e2 = 0; e2 < 4; ++e2) { const f32x4 cs = rp[e2];
            const float x1a = bf2f((unsigned short)a[2 * e2]), x2a = bf2f((unsigned short)c[2 * e2]), x1b = bf2f((unsigned short)a[2 * e2 + 1]), x2b = bf2f((unsigned short)c[2 * e2 + 1]);
            const unsigned n1 = pk_bf16(x1a * cs[0] - x2a * cs[1], x1b * cs[2] - x2b * cs[3]), n2 = pk_bf16(x1a * cs[1] + x2a * cs[0], x1b * cs[3] + x2b * cs[2]);
            a[2 * e2] = (short)(n1 & 0xffffu); a[2 * e2 + 1] = (short)(n1 >> 16); c[2 * e2] = (short)(n2 & 0xffffu); c[2 * e2 + 1] = (short)(n2 >> 16); }
        qf[DK / 16 - 2] = a; qf[DK / 16 - 1] = c;
    }
    f32x16 o0, o1;
#pragma unroll
    for (int r = 0; r < 16; ++r) { o0[r] = 0.f; o1[r] = 0.f; }
    float m_run = -INFINITY, l_run = 0.f;
    const int NT = 4 * (qb + 1), tmax_w = 4 * qb + (w >> 1);
    LAS float* wsf = (LAS float*)(lds + AT_WOFF) + w * 64; const LAS float* biasL = (const LAS float*)(lds + AT_BOFF);
    const int kc0 = tid, kv0 = kc0 / NC, c0 = kc0 % NC; const int kc1 = tid + 512, kv1 = kc1 / NC, c1 = kc1 % NC; const bool has1 = kc1 < NCH;
    const int vkv = tid >> 3, vc = tid & 7;
    u32x4 kr0, kr1 = {0u, 0u, 0u, 0u}, vr; float br = 0.f;
#define AT_LOAD(t) do { const size_t rb_ = rowbase + 64 * (size_t)(t); \
        kr0 = *(const u32x4*)(Kp + (rb_ + kv0) * ldk + 8 * c0); if (has1) kr1 = *(const u32x4*)(Kp + (rb_ + kv1) * ldk + 8 * c1); \
        vr = *(const u32x4*)(Vp + (rb_ + vkv) * ldv + 8 * vc); if (BIAS && tid < 64) br = biasp[(rb_ + tid) * 4]; } while (0)
    AT_LOAD(0);
    for (int t = 0; t < NT; ++t) {
        __syncthreads();
        *(LAS u32x4*)(lds + AT_KOFF + c0 * AT_KCH + kv0 * 16) = kr0; if (has1) *(LAS u32x4*)(lds + AT_KOFF + c1 * AT_KCH + kv1 * 16) = kr1;
        *(LAS u32x4*)(lds + AT_VOFF + (vc >> 2) * 4096 + vkv * 64 + (vc & 3) * 16) = vr; if (BIAS && tid < 64) ((LAS float*)(lds + AT_BOFF))[tid] = br;
        __syncthreads();
        if (t + 1 < NT) AT_LOAD(t + 1);
        if (t <= tmax_w) {
            f32x16 p0, p1;
#pragma unroll
            for (int r = 0; r < 16; ++r) { p0[r] = 0.f; p1[r] = 0.f; }
#pragma unroll
            for (int d0 = 0; d0 < DK / 16; ++d0) { const LAS unsigned char* kb = lds + AT_KOFF + (2 * d0 + hi) * AT_KCH + r32 * 16;
                const bf16x8 k0 = *(const LAS bf16x8*)kb, k1 = *(const LAS bf16x8*)(kb + 512);
                p0 = __builtin_amdgcn_mfma_f32_32x32x16_bf16(k0, qf[d0], p0, 0, 0, 0); p1 = __builtin_amdgcn_mfma_f32_32x32x16_bf16(k1, qf[d0], p1, 0, 0, 0); }
#pragma unroll
            for (int g = 0; g < 4; ++g) { f32x4 b0 = {0.f, 0.f, 0.f, 0.f}, b1 = {0.f, 0.f, 0.f, 0.f};
                if (BIAS) { b0 = *(const LAS f32x4*)(biasL + 8 * g + 4 * hi); b1 = *(const LAS f32x4*)(biasL + 32 + 8 * g + 4 * hi); }
#pragma unroll
                for (int i = 0; i < 4; ++i) { p0[4 * g + i] = p0[4 * g + i] * sc + b0[i]; p1[4 * g + i] = p1[4 * g + i] * sc + b1[i]; } }
            if (64 * t + 63 > q0) { const int qg = q0 + r32;
#pragma unroll
                for (int r = 0; r < 16; ++r) { const int kvg = 64 * t + crow(r, hi); if (kvg > qg) p0[r] = -INFINITY; if (kvg + 32 > qg) p1[r] = -INFINITY; } }
            float mt = fmaxf(p0[0], p1[0]);
#pragma unroll
            for (int r = 1; r < 16; ++r) mt = fmaxf(mt, fmaxf(p0[r], p1[r]));
            mt = fmaxf(mt, __shfl_xor(mt, 32));
            const float m_new = fmaxf(m_run, mt), alpha = __builtin_amdgcn_exp2f(m_run - m_new); m_run = m_new;
            float ls = 0.f;
#pragma unroll
            for (int r = 0; r < 16; ++r) { p0[r] = __builtin_amdgcn_exp2f(p0[r] - m_new); p1[r] = __builtin_amdgcn_exp2f(p1[r] - m_new); ls += p0[r] + p1[r]; }
            l_run = l_run * alpha + ls;
            if (hi == 0) wsf[r32] = alpha;
            LDS_FENCE();
#pragma unroll
            for (int g = 0; g < 4; ++g) { const f32x4 av = *(const LAS f32x4*)(wsf + 8 * g + 4 * hi);
#pragma unroll
                for (int i = 0; i < 4; ++i) { o0[4 * g + i] *= av[i]; o1[4 * g + i] *= av[i]; } }
            u32x4 pw[4];
#pragma unroll
            for (int k = 0; k < 2; ++k) {
                pw[k] = (u32x4){pk_bf16(p0[8 * k], p0[8 * k + 1]), pk_bf16(p0[8 * k + 2], p0[8 * k + 3]), pk_bf16(p0[8 * k + 4], p0[8 * k + 5]), pk_bf16(p0[8 * k + 6], p0[8 * k + 7])};
                pw[2 + k] = (u32x4){pk_bf16(p1[8 * k], p1[8 * k + 1]), pk_bf16(p1[8 * k + 2], p1[8 * k + 3]), pk_bf16(p1[8 * k + 4], p1[8 * k + 5]), pk_bf16(p1[8 * k + 6], p1[8 * k + 7])}; }
            const LAS unsigned char* vb = lds + AT_VOFF + ((lane >> 4) & 1) * 32 + (lane & 3) * 8 + (4 * hi + ((lane & 15) >> 2)) * 64;
#pragma unroll
            for (int ks = 0; ks < 4; ++ks) {
                const s16x4 l0 = vtr(vb + ks * 1024), h0 = vtr(vb + ks * 1024 + 512), l1 = vtr(vb + 4096 + ks * 1024), h1 = vtr(vb + 4096 + ks * 1024 + 512);
                const bf16x8 v0 = {l0[0], l0[1], l0[2], l0[3], h0[0], h0[1], h0[2], h0[3]}, v1 = {l1[0], l1[1], l1[2], l1[3], h1[0], h1[1], h1[2], h1[3]};
                const bf16x8 pa = __builtin_bit_cast(bf16x8, pw[ks]);
                o0 = __builtin_amdgcn_mfma_f32_32x32x16_bf16(pa, v0, o0, 0, 0, 0); o1 = __builtin_amdgcn_mfma_f32_32x32x16_bf16(pa, v1, o1, 0, 0, 0); }
            LDS_FENCE();
        }
    }
#undef AT_LOAD
    l_run += __shfl_xor(l_run, 32);
    if (hi == 0) wsf[32 + r32] = 1.0f / l_run;
    LDS_FENCE();
#pragma unroll
    for (int g = 0; g < 4; ++g) { const f32x4 rv = *(const LAS f32x4*)(wsf + 32 + 8 * g + 4 * hi);
#pragma unroll
        for (int i = 0; i < 4; ++i) { bf16* op = Op + (rowbase + q0 + 8 * g + 4 * hi + i) * 1024 + r32;
            op[0] = (bf16)(pk_bf16(o0[4 * g + i] * rv[i], 0.f) & 0xffffu); op[32] = (bf16)(pk_bf16(o1[4 * g + i] * rv[i], 0.f) & 0xffffu); } }
    LDS_FENCE();
    __syncthreads();
}

__device__ __forceinline__ void hgrn_unit(LAS unsigned char* lds, const bf16* PROJ, bf16* CAT, const float* lb_logits  , const float* norm_g  , int l, int b, int h) {
    LAS float* F = (LAS float*)lds;
    LAS float *QF = F, *KK = F + 1040, *GA = F + 2080, *LF = F + 3120, *QD = F + 4160, *KE = F + 5184, *DEC = F + 6208, *VV = F + 6272, *GO = F + 7296, *SC = F + 8320, *PI = F + 8592;
    const int tid = tid_l(), lane = tid & 63, w = __builtin_amdgcn_readfirstlane(tid >> 6);
    const int t1 = tid >> 5, a1 = 2 * (tid & 31);
    float la[2], l1p[2];
#pragma unroll
    for (int e = 0; e < 2; ++e) { float lbv = 0.f; if (l == 1) { const float z0 = lb_logits[64 * h + a1 + e], z1 = lb_logits[256 + 64 * h + a1 + e]; lbv = 1.0f / (1.0f + expf(z0 - z1)); }
        la[e] = logf(fmaxf(lbv, 1e-30f)); l1p[e] = log1pf(-lbv); }
    const float ng0 = norm_g[64 * h + a1], ng1 = norm_g[64 * h + a1 + 1];
    float st[8];
#pragma unroll
    for (int j = 0; j < 8; ++j) st[j] = 0.f;
    for (int c = 0; c < 128; ++c) {
        const size_t r0 = (size_t)b * SEQ + 16 * c;
        {
            const bf16* prow = PROJ + (r0 + t1) * NMIX + 64 * h + a1;
            const unsigned uq = *(const unsigned*)(prow + PC_AQ), uf = *(const unsigned*)(prow + PC_AF), ui = *(const unsigned*)(prow + PC_AI), ug = *(const unsigned*)(prow + PC_AG);
#pragma unroll
            for (int e = 0; e < 2; ++e) { const float q = e ? bfhi(uq) : bflo(uq), z = e ? bfhi(uf) : bflo(uf), iv = e ? bfhi(ui) : bflo(ui), gv = e ? bfhi(ug) : bflo(ug);
                const float lsig = fminf(z, 0.f) - log1pf(expf(-fabsf(z))); const float bb = l1p[e] + lsig; const float mx = fmaxf(la[e], bb);
                const float lf = mx + log1pf(expf(-fabsf(la[e] - bb)));
                QF[t1 * 65 + a1 + e] = silu_x(q); LF[t1 * 65 + a1 + e] = lf; KK[t1 * 65 + a1 + e] = -expm1f(lf); VV[t1 * 64 + a1 + e] = iv; GO[t1 * 64 + a1 + e] = gv; }
        }
        __syncthreads();
        {
#pragma unroll
            for (int e = 0; e < 2; ++e) { const int a = a1 + e; float pre = 0.f, tot = 0.f;
#pragma unroll
                for (int tt = 0; tt < 16; ++tt) { const float x = LF[tt * 65 + a]; tot += x; if (tt <= t1) pre += x; }
                GA[t1 * 65 + a] = pre; QD[t1 * 64 + a] = QF[t1 * 65 + a] * expf(pre); KE[t1 * 64 + a] = KK[t1 * 65 + a] * expf(tot - pre); if (t1 == 15) DEC[a] = expf(tot); }
        }
        __syncthreads();
        {
#pragma unroll
            for (int tt = 0; tt < 16; ++tt) { const f32x4 qa = *(const LAS f32x4*)(QD + tt * 64 + 8 * w), qb_ = *(const LAS f32x4*)(QD + tt * 64 + 8 * w + 4);
                PI[(w * 16 + tt) * 64 + lane] = (qa[0] * st[0] + qa[1] * st[1]) + (qa[2] * st[2] + qa[3] * st[3]) + (qb_[0] * st[4] + qb_[1] * st[5]) + (qb_[2] * st[6] + qb_[3] * st[7]); }
            { const f32x4 da = *(const LAS f32x4*)(DEC + 8 * w), db = *(const LAS f32x4*)(DEC + 8 * w + 4);
              st[0] *= da[0]; st[1] *= da[1]; st[2] *= da[2]; st[3] *= da[3]; st[4] *= db[0]; st[5] *= db[1]; st[6] *= db[2]; st[7] *= db[3]; }
#pragma unroll
            for (int s = 0; s < 16; ++s) { const float vv = VV[s * 64 + lane]; const f32x4 ka = *(const LAS f32x4*)(KE + s * 64 + 8 * w), kb = *(const LAS f32x4*)(KE + s * 64 + 8 * w + 4);
                st[0] += ka[0] * vv; st[1] += ka[1] * vv; st[2] += ka[2] * vv; st[3] += ka[3] * vv; st[4] += kb[0] * vv; st[5] += kb[1] * vv; st[6] += kb[2] * vv; st[7] += kb[3] * vv; }
            const int p = tid >> 1, half = tid & 1, tq = p >> 4, sk = p & 15; float val = 0.f;
            if (sk <= tq) {
#pragma unroll 8
                for (int a = 32 * half; a < 32 * half + 32; ++a) val += QF[tq * 65 + a] * KK[sk * 65 + a] * expf(GA[tq * 65 + a] - GA[sk * 65 + a]); }
            val += __shfl_xor(val, 1);
            if (half == 0) SC[tq * 17 + sk] = val;
        }
        __syncthreads();
        {
            float o[2];
#pragma unroll
            for (int e = 0; e < 2; ++e) { const int v = a1 + e; float s = 0.f;
#pragma unroll
                for (int ww = 0; ww < 8; ++ww) s += PI[(ww * 16 + t1) * 64 + v];
                for (int sk = 0; sk <= t1; ++sk) s += SC[t1 * 17 + sk] * VV[sk * 64 + v];
                o[e] = s; }
            float ss = o[0] * o[0] + o[1] * o[1];
#pragma unroll
            for (int of = 1; of < 32; of <<= 1) ss += __shfl_xor(ss, of);
            const float r = 1.f / sqrtf(ss * (1.f / 64) + RMS_EPS_C);
            const float y0 = o[0] * r * ng0 * silu_x(GO[t1 * 64 + a1]), y1 = o[1] * r * ng1 * silu_x(GO[t1 * 64 + a1 + 1]);
            *(unsigned*)(CAT + (r0 + t1) * 1024 + 64 * h + a1) = pk_bf16(y0, y1);
        }
        __syncthreads();
    }
}

__device__ __forceinline__ void gmlp_unit(LAS unsigned char* lds, const bf16* PROJ, bf16* CAT, const float* lng, const float* lnb, const float* __restrict__ ws_, const float* bs, int b, int ci) {
    LAS float* VT = (LAS float*)lds;
    const int tid = tid_l(), lane = tid & 63, w = __builtin_amdgcn_readfirstlane(tid >> 6);
    const size_t r0 = (size_t)b * SEQ + 128 * ci;
    { const f32x4 gv = ((const f32x4*)lng)[lane], bv = ((const f32x4*)lnb)[lane];
      for (int tt = 16 * w; tt < 16 * w + 16; ++tt) { const u32x2 u = *(const u32x2*)(PROJ + (r0 + tt) * NMIX + PC_DV + 4 * lane);
        f32x4 x = {gelu_tanh(bflo(u.x)), gelu_tanh(bfhi(u.x)), gelu_tanh(bflo(u.y)), gelu_tanh(bfhi(u.y))};
        const float mean = wave_sum((x[0] + x[1]) + (x[2] + x[3])) * (1.f / 256); x = x - mean;
        const float rstd = 1.f / sqrtf(wave_sum((x[0] * x[0] + x[1] * x[1]) + (x[2] * x[2] + x[3] * x[3])) * (1.f / 256) + LN_EPS_C);
        *(LAS f32x4*)(VT + tt * 256 + 4 * lane) = x * rstd * gv + bv; } }
    __syncthreads();
    { const int c = tid & 255, th = w >> 2, g = w & 3; const float* wg = ws_ + (size_t)g * 128 * 128;
      for (int j = 0; j < 8; ++j) { const int tb = th + 16 * j; float acc[8];
#pragma unroll
        for (int i = 0; i < 8; ++i) acc[i] = 0.f;
        for (int s = 0; s <= tb + 14; ++s) { const float v = VT[s * 256 + c];
#pragma unroll
            for (int i = 0; i < 8; ++i) { const int ti = tb + 2 * i; const float wv = (s <= ti) ? wg[ti * 128 + s] : 0.f; acc[i] += wv * v; } }
#pragma unroll
        for (int i = 0; i < 8; ++i) { const int ti = tb + 2 * i; const float mixed = acc[i] + bs[g * 128 + ti];
            const float u = gelu_tanh(bf2f(PROJ[(r0 + ti) * NMIX + PC_DU + c]));
            CAT[(r0 + ti) * 1024 + 768 + c] = (bf16)(pk_bf16(u * mixed, 0.f) & 0xffffu); } } }
    __syncthreads();
}

__device__ __forceinline__ void mixer_phase(ArgsP ap0, LAS unsigned char* lds, int l) {
    volatile LAS int* slot = (volatile LAS int*)(lds + MISC_OFF);
    constexpr int NU = 64 + 1024 + 256;
    for (;;) {
        ArgsP ap = launder(ap0);
        unsigned char* ws = ap->ws; const bf16* PROJ = (const bf16*)(ws + WS_HID); bf16* CAT = (bf16*)(ws + WS_CAT);
        __syncthreads();
        if (tid_l() == 0) *slot = (int)atomicAdd((unsigned*)(ws + WS_CTL) + 64 * (1 + l), 1u);
        __syncthreads();
        const int u = __builtin_amdgcn_readfirstlane(*slot);
        if (u >= NU) break;
        if (u < 64) { hgrn_unit(lds, PROJ, CAT, ap->in[12], ap->in[13] + l * 256, l, u >> 2, u & 3); }
        else if (u < 64 + 1024) { const int ai = u - 64, qb = 7 - (ai >> 7), rem = ai & 127, ty = rem & 1, bh = rem >> 1, b = bh >> 2, h = bh & 3;
            if (ty == 0) attn_unit<96, false, true>(lds, (const bf16*)(ws + WS_QM) + 96 * h, 384, (const bf16*)(ws + WS_KM) + 96 * h, 384, (const bf16*)(ws + WS_VM) + 64 * h, 256, nullptr, (const float*)(ws + WS_ROPE), 1.0f, CAT + 256 + 64 * h, b, qb);
            else attn_unit<64, true, false>(lds, PROJ + PC_CQ + 64 * h, NMIX, PROJ + PC_CK + 64 * h, NMIX, PROJ + PC_CV + 64 * h, NMIX, (const float*)(ws + WS_FNEG) + h, nullptr, 0.125f * LOG2E, CAT + 512 + 64 * h, b, qb); }
        else { const int gi = u - 64 - 1024; gmlp_unit(lds, PROJ, CAT, ap->in[19] + l * 256, ap->in[20] + l * 256, ap->in[21] + (size_t)l * 4 * 128 * 128, ap->in[22] + l * 512, gi >> 4, gi & 15); }
    }
}

__device__ __forceinline__ void run_phase(ArgsP ap0, LAS unsigned char* lds, int ph) {
    ArgsP ap = launder(ap0);
    unsigned char* ws = ap->ws; float* X = ap->out; float* mod = (float*)(ws + WS_MOD);
    bf16* H = (bf16*)(ws + WS_H); bf16* HID = (bf16*)(ws + WS_HID); bf16* CAT = (bf16*)(ws + WS_CAT);
    const int G = gdim_l(), bx = bid_l();
    if (ph == 0) { p0_prologue(ap, lds); return; }
    if (ph == 1) { ln_phase(ap->in[0], X, H, nullptr, nullptr, mod + 0 * 1024, mod + 1 * 1024, false); return; }
    const int l = (ph - 2) / 13, sp = (ph - 2) % 13; const float* modl = mod + (size_t)l * 16 * NMOD;
    if (sp == 0 || sp == 10) {
        const int f = sp == 10; pg8::Gemm g{H, (const bf16*)(ws + WS_WIN + (size_t)(f * 2 + l) * WIN_SZ), MROWS, 2 * DFF, DM}; pg8::StaticOrder S; S.init(MROWS, 2 * DFF, G, bx);
        pg8::EpiSwiGLU E{HID, DFF}; pg8::gemm_phase<pg8::EpiSwiGLU, pg8::StaticOrder, true, true>(lds, g, S, E);
    } else if (sp == 1 || sp == 11) {
        const int f = sp == 11; pg8::Gemm g{HID, (const bf16*)(ws + WS_WOUT + (size_t)(f * 2 + l) * WOUT_SZ), MROWS, DM, DFF}; pg8::StaticOrder S; S.init(MROWS, DM, G, bx);
        pg8::EpiResid E{X, modl + (f ? 8 : 2) * 1024, 0.5f, ALPHA_C}; pg8::gemm_phase<pg8::EpiResid, pg8::StaticOrder, true, true>(lds, g, S, E);
    } else if (sp == 2 || sp == 9 || sp == 12) {
        const int i = sp == 2 ? 0 : (sp == 9 ? 1 : 2); const float* g_ = ap->in[4] + (size_t)(l * 3 + i) * DM; const float* b_ = ap->in[5] + (size_t)(l * 3 + i) * DM;
        const bool last = (sp == 12 && l == 1); const float* mnext = (sp == 12) ? (mod + (size_t)(l + 1) * 16 * NMOD) : (modl + (size_t)(3 * (i + 1)) * 1024);
        ln_phase(nullptr, X, last ? nullptr : H, g_, b_, last ? nullptr : mnext, last ? nullptr : mnext + 1024, true);
    } else if (sp == 3) {
        pg8::Gemm g{H, (const bf16*)(ws + WS_WMIX + (size_t)l * WMIX_SZ), MROWS, NMIX, DM}; pg8::StaticOrder S; S.init(MROWS, NMIX, G, bx);
        pg8::EpiBf16<0> E{HID, NMIX, nullptr, 0, 0, 1.f}; pg8::gemm_phase<pg8::EpiBf16<0>, pg8::StaticOrder, true, true>(lds, g, S, E);
    } else if (sp == 4) {
        prep_phase(HID, (bf16*)(ws + WS_CQN), (bf16*)(ws + WS_CKVN), (bf16*)(ws + WS_KM), (float*)(ws + WS_FNEG), (const float*)(ws + WS_ROPE), ap->in[14] + l * 256, ap->in[15] + l * 128, ap->in[18] + l * 4);
    } else if (sp == 5) {
        { pg8::Gemm g{(const bf16*)(ws + WS_CQN), (const bf16*)(ws + WS_WUQ + (size_t)l * WUQ_SZ), MROWS, 512, opaque_i(256)}; pg8::StaticOrder S; S.init(MROWS, 512, G, bx);
          pg8::EpiQup E{(bf16*)(ws + WS_QM), 0.10206207261596575f * LOG2E}; pg8::gemm_phase<pg8::EpiQup, pg8::StaticOrder, true, true>(lds, g, S, E); }
    } else if (sp == 6) {
        { pg8::Gemm g{(const bf16*)(ws + WS_CKVN), (const bf16*)(ws + WS_WUKV + (size_t)l * WUKV_SZ), MROWS, 512, opaque_i(128)}; pg8::StaticOrder S; S.init(MROWS, 512, G, bx);
          pg8::EpiKVup E{(bf16*)(ws + WS_KM), (bf16*)(ws + WS_VM)}; pg8::gemm_phase<pg8::EpiKVup, pg8::StaticOrder, true, true>(lds, g, S, E); }
    } else if (sp == 7) {
        mixer_phase(ap0, lds, l);
    } else if (sp == 8) {
        pg8::Gemm g{CAT, (const bf16*)(ws + WS_WMO + (size_t)l * WMO_SZ), MROWS, DM, DM}; pg8::StaticOrder S; S.init(MROWS, DM, G, bx);
        pg8::EpiResid E{X, modl + 5 * 1024, 1.0f, ALPHA_C}; pg8::gemm_phase<pg8::EpiResid, pg8::StaticOrder, true, true>(lds, g, S, E);
    }
}
__global__ void __launch_bounds__(512, 2) fwd_kernel(Args A) {
    extern __shared__ __attribute__((aligned(16))) unsigned char lds_raw[];
    LAS unsigned char* lds = (LAS unsigned char*)lds_raw;
    cg::grid_group grid = cg::this_grid();
    ArgsP ap0 = (ArgsP)__builtin_amdgcn_kernarg_segment_ptr();
    const int lo = A.ph_lo, hi = A.ph_hi;
    for (int ph = lo; ph < hi; ++ph) {
        run_phase(ap0, lds, ph);
        if (ph + 1 < hi) grid.sync();
    }
}

extern "C" void kernel_launch(void* const* d_in, const int* in_sizes, int n_in, void* d_out, int out_size, void* d_ws, size_t ws_size, hipStream_t stream) {
    static int grid = 0;
    if (grid == 0) {
        if (n_in != 23 || out_size != MROWS * DM || ws_size < WS_END) { fprintf(stderr, "kernel_launch: unexpected shapes (n_in %d out %d ws %zu)\n", n_in, out_size, ws_size); grid = -1; return; }
        int dev = 0, cus = 0, per_cu = 0;
        hipGetDevice(&dev); hipDeviceGetAttribute(&cus, hipDeviceAttributeMultiprocessorCount, dev);
        if (hipFuncSetAttribute((const void*)fwd_kernel, hipFuncAttributeMaxDynamicSharedMemorySize, LDS_BYTES) != hipSuccess) { fprintf(stderr, "kernel_launch: hipFuncSetAttribute failed\n"); grid = -1; return; }
        hipOccupancyMaxActiveBlocksPerMultiprocessor(&per_cu, (const void*)fwd_kernel, 512, LDS_BYTES);
        (void)hipGetLastError();
        if (per_cu < 1) { fprintf(stderr, "kernel_launch: occupancy query says %d blocks per CU\n", per_cu); per_cu = 1; }
        grid = cus;
    }
    if (grid < 0) return;
    hipMemsetAsync((char*)d_ws + WS_CTL, 0, 4096, stream);
    Args a{};
    for (int i = 0; i < 23; ++i) a.in[i] = (const float*)d_in[i];
    a.out = (float*)d_out; a.ws = (unsigned char*)d_ws;
#if MK_PER_PHASE
    for (int ph = 0; ph < NPHASE; ++ph) { a.ph_lo = ph; a.ph_hi = ph + 1; hipLaunchKernelGGL(fwd_kernel, dim3(grid), dim3(512), LDS_BYTES, stream, a); }
#else
    a.ph_lo = 0; a.ph_hi = NPHASE;
    void* args[] = {&a};
    hipError_t e = hipLaunchCooperativeKernel((const void*)fwd_kernel, dim3(grid), dim3(512), args, LDS_BYTES, stream);
    if (e != hipSuccess) fprintf(stderr, "cooperative launch failed: %s (grid %d)\n", hipGetErrorString(e), grid);
#endif
}
```

```cpp
#include <hip/hip_runtime.h>
#include <hip/hip_cooperative_groups.h>
#include <cstdio>
#include <cstdint>
#include <cmath>
__device__ __forceinline__ int tid_l() { int t = threadIdx.x; asm volatile("" : "+v"(t)); return t; }
__device__ __forceinline__ int bid_l() { int t = blockIdx.x; asm volatile("" : "+s"(t)); return t; }
__device__ __forceinline__ int opaque_i(int v) { asm volatile("" : "+s"(v)); return v; }
__device__ __forceinline__ int gdim_l() { int t = gridDim.x; asm volatile("" : "+s"(t)); return t; }
namespace pg8 {
#define PG8_LAS __attribute__((address_space(3)))
typedef unsigned short bf16_t;
typedef short bf16x8 __attribute__((ext_vector_type(8)));
typedef float f32x4 __attribute__((ext_vector_type(4)));
typedef unsigned u32x4 __attribute__((ext_vector_type(4)));
constexpr int BM = 256, BK = 64, HALF = 128, HTB = HALF * BK * 2  , STAGE_BYTES = 8 * HTB, NXCD = 8, WGM = 8;

__host__ __device__ __forceinline__ int lds_byte(int r, int c) { const int st = (r >> 4) * 2 + (c >> 5), rr = r & 15, cc = c & 31, ob = rr * 64 + cc * 2; return st * 1024 + (ob ^ (((ob >> 9) & 1) << 5)); }
__host__ __device__ __forceinline__ void stage_rc(int b, int& R, int& C) { const int st = b / 1024, sb = b % 1024, swz = sb ^ (((sb >> 9) & 1) << 5); R = (st >> 1) * 16 + swz / 64; C = (st & 1) * 32 + (swz % 64) / 2; }
__host__ __device__ __forceinline__ int perm32(int rho) { const int n = rho >> 4, i = rho & 15; return 8 * (i >> 2) + 4 * n + (i & 3); }

struct Unit { int pm, pn; };
struct Gemm { const bf16_t* A; const bf16_t* Bt; int M, N, K; };

struct StaticOrder {
    int nM, nN, nwg, G, c;
    __host__ __device__ void init(int M, int N, int G_, int c_) { nM = M / BM; nN = N / BM; nwg = nM * nN; G = G_; c = c_; }
    __host__ __device__ bool next(int i, Unit& u) const {
        const long L = (long)i * G + c; if (L >= nwg) return false;
        int wgid = (int)L; { const int q = nwg / NXCD, r = nwg % NXCD, xcd = wgid % NXCD, off = wgid / NXCD; wgid = (xcd < r ? xcd * (q + 1) : r * (q + 1) + (xcd - r) * q) + off; }
        const int nig = WGM * nN, gid = wgid / nig, fm = gid * WGM, gsz = (nM - fm) < WGM ? (nM - fm) : WGM;
        u.pm = fm + ((wgid % nig) % gsz); u.pn = (wgid % nig) / gsz; return true;
    }
    __device__ __forceinline__ void a_ready(const Unit&) const {}
    __device__ __forceinline__ void done(const Unit&) const {}
};

__device__ __forceinline__ unsigned cvt_pk_bf16(float lo, float hi) { unsigned r; asm volatile("v_cvt_pk_bf16_f32 %0, %1, %2" : "=v"(r) : "v"(lo), "v"(hi)); return r; }
typedef float f32x2 __attribute__((ext_vector_type(2)));
__device__ __forceinline__ f32x2 gelu_pk(f32x2 v) {
    const f32x2 av = __builtin_elementwise_abs(v), d = av * 0.2316418882f + 1.0f;
    f32x2 t; t.x = __builtin_amdgcn_rcpf(d.x); t.y = __builtin_amdgcn_rcpf(d.y);
    f32x2 q = t * 0.5307027145f + (-0.7265760135f); q = q * t + 0.7107068705f; q = q * t + (-0.142248368f); q = q * t + 0.127414796f; q = q * t;
    const f32x2 s = (v * v) * (-0.72134752044f);
    f32x2 e; e.x = __builtin_amdgcn_exp2f(s.x); e.y = __builtin_amdgcn_exp2f(s.y);
    const f32x2 m = v * (q * e), r = v - m;
    f32x2 o; o.x = v.x < 0.f ? m.x : r.x; o.y = v.y < 0.f ? m.y : r.y; return o;
}

template <int ACT  > struct EpiBf16 {
    static constexpr bool PERM = true, AFTER_DRAIN = false; static_assert(ACT == 0 || ACT == 1, "EpiBf16: ACT is 0 (none) or 1 (gelu_pk)");
    bf16_t* O; int ldc; const float* bias; int split_cols; size_t split_stride; float scale0;
    __device__ __forceinline__ void operator()(const f32x4 (&acc)[2][2][4][2], const Unit& u, int wr, int wc, int fr, int fq) const {
        const int row0 = u.pm * BM + wr * 64 + fr; int colt = u.pn * BM; bf16_t* base = O;
        float sc = 1.f; if (split_cols) { const int t = colt / split_cols; base += (size_t)t * split_stride; colt -= t * split_cols; if (t == 0) sc = scale0; }
        const int col0 = colt + wc * 32 + 8 * fq, bcol0 = u.pn * BM + wc * 32 + 8 * fq;
        f32x4 bv[2][2];
#pragma unroll
        for (int bj = 0; bj < 2; ++bj)
#pragma unroll
            for (int n = 0; n < 2; ++n) bv[bj][n] = bias ? *(const f32x4*)(bias + bcol0 + bj * HALF + 4 * n) : (f32x4){0.f, 0.f, 0.f, 0.f};
#pragma unroll
        for (int ai = 0; ai < 2; ++ai)
#pragma unroll
            for (int m = 0; m < 4; ++m) { bf16_t* rowp = base + (size_t)(row0 + ai * HALF + m * 16) * ldc + col0;
#pragma unroll
                for (int bj = 0; bj < 2; ++bj) { f32x4 v0 = acc[ai][bj][m][0] + bv[bj][0], v1 = acc[ai][bj][m][1] + bv[bj][1];
                    if (ACT == 1) { f32x2 a = gelu_pk((f32x2){v0[0], v0[1]}), b = gelu_pk((f32x2){v0[2], v0[3]}), c = gelu_pk((f32x2){v1[0], v1[1]}), d = gelu_pk((f32x2){v1[2], v1[3]});
                        v0 = (f32x4){a.x, a.y, b.x, b.y}; v1 = (f32x4){c.x, c.y, d.x, d.y}; }
                    v0 = v0 * sc; v1 = v1 * sc; u32x4 w; w.x = cvt_pk_bf16(v0[0], v0[1]); w.y = cvt_pk_bf16(v0[2], v0[3]); w.z = cvt_pk_bf16(v1[0], v1[1]); w.w = cvt_pk_bf16(v1[2], v1[3]);
                    *(u32x4*)(rowp + bj * HALF) = w; } }
    }
};
__device__ __forceinline__ float silu_f(float x) { return x * __builtin_amdgcn_rcpf(1.0f + __expf(-x)); }
struct EpiSwiGLU {
    static constexpr bool PERM = true, AFTER_DRAIN = false;
    bf16_t* O; int ldc;
    __device__ __forceinline__ void operator()(const f32x4 (&acc)[2][2][4][2], const Unit& u, int wr, int wc, int fr, int fq) const {
        const int row0 = u.pm * BM + wr * 64 + fr, col0 = u.pn * HALF + wc * 32 + 8 * fq;
#pragma unroll
        for (int ai = 0; ai < 2; ++ai)
#pragma unroll
            for (int m = 0; m < 4; ++m) { bf16_t* rowp = O + (size_t)(row0 + ai * HALF + m * 16) * ldc + col0;
                const f32x4 g0 = acc[ai][0][m][0], g1 = acc[ai][0][m][1], u0 = acc[ai][1][m][0], u1 = acc[ai][1][m][1];
                u32x4 w; w.x = cvt_pk_bf16(silu_f(g0[0]) * u0[0], silu_f(g0[1]) * u0[1]); w.y = cvt_pk_bf16(silu_f(g0[2]) * u0[2], silu_f(g0[3]) * u0[3]);
                w.z = cvt_pk_bf16(silu_f(g1[0]) * u1[0], silu_f(g1[1]) * u1[1]); w.w = cvt_pk_bf16(silu_f(g1[2]) * u1[2], silu_f(g1[3]) * u1[3]);
                *(u32x4*)rowp = w; }
    }
};
struct EpiResid {
    static constexpr bool PERM = false, AFTER_DRAIN = false;
    float* X; const float* gate; float gs, alpha;
    __device__ __forceinline__ void operator()(const f32x4 (&acc)[2][2][4][2], const Unit& u, int wr, int wc, int fr, int fq) const {
        const float* gp = gate + (size_t)(u.pm >> 3) * 9216; const int col0 = u.pn * BM + wc * 32 + 4 * fq;
#pragma unroll
        for (int bj = 0; bj < 2; ++bj)
#pragma unroll
            for (int n = 0; n < 2; ++n) { const int c = col0 + bj * HALF + n * 16; f32x4 gv = *(const f32x4*)(gp + c); gv = (gv + 1.0f) * gs;
#pragma unroll
                for (int ai = 0; ai < 2; ++ai)
#pragma unroll
                    for (int m = 0; m < 4; ++m) { float* p = X + (size_t)(u.pm * BM + ai * HALF + wr * 64 + m * 16 + fr) * 1024 + c;
                        const f32x4 xv = *(const f32x4*)p; *(f32x4*)p = xv * alpha + gv * acc[ai][bj][m][n]; } }
    }
};
struct EpiQup {
    static constexpr bool PERM = true, AFTER_DRAIN = false;
    bf16_t* Q; float qs;
    __device__ __forceinline__ void operator()(const f32x4 (&acc)[2][2][4][2], const Unit& u, int wr, int wc, int fr, int fq) const {
#pragma unroll
        for (int bj = 0; bj < 2; ++bj) {
            if (u.pn * 2 + bj >= 3) continue;
            const int col0 = u.pn * BM + bj * HALF + wc * 32 + 8 * fq;
#pragma unroll
            for (int ai = 0; ai < 2; ++ai)
#pragma unroll
                for (int m = 0; m < 4; ++m) { const size_t row = (size_t)(u.pm * BM + ai * HALF + wr * 64 + m * 16 + fr);
                    const f32x4 v0 = acc[ai][bj][m][0] * qs, v1 = acc[ai][bj][m][1] * qs;
                    u32x4 w; w.x = cvt_pk_bf16(v0[0], v0[1]); w.y = cvt_pk_bf16(v0[2], v0[3]); w.z = cvt_pk_bf16(v1[0], v1[1]); w.w = cvt_pk_bf16(v1[2], v1[3]);
                    *(u32x4*)(Q + row * 384 + col0) = w; }
        }
    }
};
struct EpiKVup {
    static constexpr bool PERM = true, AFTER_DRAIN = false;
    bf16_t* Kb; bf16_t* Vb;
    __device__ __forceinline__ void operator()(const f32x4 (&acc)[2][2][4][2], const Unit& u, int wr, int wc, int fr, int fq) const {
#pragma unroll
        for (int bj = 0; bj < 2; ++bj) { const int h = 2 * u.pn + bj, dd = wc * 32 + 8 * fq;
#pragma unroll
            for (int ai = 0; ai < 2; ++ai)
#pragma unroll
                for (int m = 0; m < 4; ++m) { const size_t row = (size_t)(u.pm * BM + ai * HALF + wr * 64 + m * 16 + fr);
                    const f32x4 v0 = acc[ai][bj][m][0], v1 = acc[ai][bj][m][1];
                    u32x4 w; w.x = cvt_pk_bf16(v0[0], v0[1]); w.y = cvt_pk_bf16(v0[2], v0[3]); w.z = cvt_pk_bf16(v1[0], v1[1]); w.w = cvt_pk_bf16(v1[2], v1[3]);
                    bf16_t* p = (dd < 64) ? (Kb + row * 384 + 96 * h + dd) : (Vb + row * 256 + 64 * h + (dd - 64));
                    *(u32x4*)p = w; } }
    }
};
template <class Epi, class Sched, bool ALIGN_EPI = false, bool SP2 = false>
__device__ __forceinline__ void gemm_phase(PG8_LAS unsigned char* lds, const Gemm g, const Sched& S, const Epi& E) {
    const int tid = tid_l(), wid = __builtin_amdgcn_readfirstlane(tid >> 6), lane = tid & 63, wr = wid >> 2, wc = wid & 3, fr = lane & 15, fq = lane >> 4;
    const int K = g.K, nt = K / BK;
    unsigned voffA[2], voffB[2];
#pragma unroll
    for (int i = 0; i < 2; ++i) { int R, C; stage_rc(tid * 16 + i * 8192, R, C); const int Rb = Epi::PERM ? ((R & ~31) + perm32(R & 31)) : R;
        voffA[i] = (unsigned)(R * K + C) * 2u; voffB[i] = (unsigned)(Rb * K + C) * 2u; }
    const size_t kstep = (size_t)(BK * 2);
    const size_t hstep = (size_t)HALF * K * 2;
    const size_t tstep = 2 * hstep;
    const unsigned ldsw = (unsigned)wid * 1024u;
    const int aoff = lds_byte(wr * 64 + fr, fq * 8), boff = lds_byte(wc * 32 + fr, fq * 8);
#define PG8_SA(b, h) (((b) * 2 + (h)) * HTB)
#define PG8_SB(b, h) ((4 + (b) * 2 + (h)) * HTB)
#define PG8_STAGE(bufoff, gbase, voff) do { _Pragma("unroll") for (int _i = 0; _i < 2; ++_i) \
        __builtin_amdgcn_global_load_lds((const unsigned*)((const char*)(gbase) + (voff)[_i]), (PG8_LAS unsigned*)(lds + (bufoff) + ldsw + _i * 8192), 16, 0, 0); } while (0)
#define PG8_LDA(dst, b, h) do { _Pragma("unroll") for (int m = 0; m < 4; ++m) _Pragma("unroll") for (int k = 0; k < 2; ++k) dst[m][k] = *(const PG8_LAS bf16x8*)(lds + PG8_SA(b, h) + aoff + m * 2048 + k * 1024); } while (0)
#define PG8_LDB(dst, b, h) do { _Pragma("unroll") for (int n = 0; n < 2; ++n) _Pragma("unroll") for (int k = 0; k < 2; ++k) dst[n][k] = *(const PG8_LAS bf16x8*)(lds + PG8_SB(b, h) + boff + n * 2048 + k * 1024); } while (0)
#define PG8_MMA(ai, bj, At, Bt) do { __builtin_amdgcn_s_setprio(1); _Pragma("unroll") for (int m = 0; m < 4; ++m) _Pragma("unroll") for (int n = 0; n < 2; ++n) _Pragma("unroll") for (int k = 0; k < 2; ++k) \
        acc[ai][bj][m][n] = __builtin_amdgcn_mfma_f32_16x16x32_bf16(Bt[n][k], At[m][k], acc[ai][bj][m][n], 0, 0, 0); __builtin_amdgcn_s_setprio(0); } while (0)
#define PG8_WAIT_V(n) asm volatile("s_waitcnt vmcnt(" #n ")" ::: "memory")
#define PG8_WAIT_L(n) asm volatile("s_waitcnt lgkmcnt(" #n ")" ::: "memory")
#define PG8_BAR __builtin_amdgcn_s_barrier()
#define PG8_SCHED __builtin_amdgcn_sched_barrier(0)
    Unit cur, nxt; int ui = 0;
    if (!S.next(0, cur)) return;
    f32x4 acc[2][2][4][2];
#pragma unroll
    for (int a = 0; a < 2; ++a)
#pragma unroll
        for (int b = 0; b < 2; ++b)
#pragma unroll
            for (int m = 0; m < 4; ++m)
#pragma unroll
                for (int n = 0; n < 2; ++n) acc[a][b][m][n] = (f32x4){0.f, 0.f, 0.f, 0.f};
    bf16x8 At[4][2], B0[2][2], B1[2][2];
    const char* cA = (const char*)g.A + (size_t)cur.pm * tstep; const char* cB = (const char*)g.Bt + (size_t)cur.pn * tstep;
    S.a_ready(cur);
    if constexpr (SP2) {
        PG8_STAGE(PG8_SB(0, 0), cB, voffB); PG8_STAGE(PG8_SB(0, 1), cB + hstep, voffB); PG8_STAGE(PG8_SA(0, 0), cA, voffA); PG8_STAGE(PG8_SA(0, 1), cA + hstep, voffA);
        if (wr == 1) PG8_BAR;
        PG8_WAIT_V(2); PG8_BAR;
        PG8_STAGE(PG8_SB(1, 0), cB + kstep, voffB); PG8_STAGE(PG8_SA(1, 0), cA + kstep, voffA); PG8_STAGE(PG8_SB(1, 1), cB + hstep + kstep, voffB);
        PG8_WAIT_V(6); PG8_BAR;
    } else {
        PG8_STAGE(PG8_SB(0, 0), cB, voffB); PG8_STAGE(PG8_SA(0, 0), cA, voffA); PG8_STAGE(PG8_SB(0, 1), cB + hstep, voffB); PG8_STAGE(PG8_SA(0, 1), cA + hstep, voffA);
        if (wr == 1) PG8_BAR;
        PG8_WAIT_V(4); PG8_BAR;
        PG8_STAGE(PG8_SB(1, 0), cB + kstep, voffB); PG8_STAGE(PG8_SA(1, 0), cA + kstep, voffA); PG8_STAGE(PG8_SB(1, 1), cB + hstep + kstep, voffB);
        PG8_WAIT_V(6); PG8_BAR;
    }
    for (;;) {
        const bool has_next = S.next(ui + 1, nxt);
        const char* nA = has_next ? (const char*)g.A + (size_t)nxt.pm * tstep : cA; const char* nB = has_next ? (const char*)g.Bt + (size_t)nxt.pn * tstep : cB;
        for (int t = 0; t < nt; t += 2) {
            const bool last = (t == nt - 2);
            const char* a1 = cA + (size_t)(t + 1) * kstep;
            const char* a2 = last ? nA : cA + (size_t)(t + 2) * kstep; const char* b2 = last ? nB : cB + (size_t)(t + 2) * kstep;
            const char* a3 = a2 + kstep; const char* b3 = b2 + kstep;
            if (last && has_next) S.a_ready(nxt);
            if constexpr (SP2) {
            PG8_LDB(B0, 0, 0); PG8_LDB(B1, 0, 1); PG8_SCHED; PG8_LDA(At, 0, 0); PG8_STAGE(PG8_SA(1, 1), a1 + hstep, voffA);
            PG8_WAIT_V(8); PG8_WAIT_L(0); PG8_BAR; PG8_MMA(0, 0, At, B0); PG8_MMA(0, 1, At, B1); PG8_BAR; PG8_SCHED;
            PG8_LDA(At, 0, 1); PG8_STAGE(PG8_SB(0, 0), b2, voffB); PG8_STAGE(PG8_SB(0, 1), b2 + hstep, voffB); PG8_STAGE(PG8_SA(0, 0), a2, voffA);
            PG8_WAIT_V(8); PG8_WAIT_L(0); PG8_BAR; PG8_MMA(1, 0, At, B0); PG8_MMA(1, 1, At, B1); PG8_BAR; PG8_SCHED;
            PG8_LDB(B0, 1, 0); PG8_LDB(B1, 1, 1); PG8_SCHED; PG8_LDA(At, 1, 0); PG8_STAGE(PG8_SA(0, 1), a2 + hstep, voffA);
            PG8_WAIT_V(8); PG8_WAIT_L(0); PG8_BAR; PG8_MMA(0, 0, At, B0); PG8_MMA(0, 1, At, B1); PG8_BAR; PG8_SCHED;
            PG8_LDA(At, 1, 1); PG8_STAGE(PG8_SB(1, 0), b3, voffB); PG8_STAGE(PG8_SB(1, 1), b3 + hstep, voffB); PG8_STAGE(PG8_SA(1, 0), a3, voffA);
            PG8_WAIT_V(8); PG8_WAIT_L(0); PG8_BAR; PG8_MMA(1, 0, At, B0); PG8_MMA(1, 1, At, B1); PG8_BAR; PG8_SCHED;
            } else {
            PG8_LDB(B0, 0, 0); PG8_SCHED; PG8_LDA(At, 0, 0); PG8_STAGE(PG8_SA(1, 1), a1 + hstep, voffA);
            PG8_WAIT_L(8); PG8_BAR; PG8_WAIT_L(0); PG8_MMA(0, 0, At, B0); PG8_BAR; PG8_SCHED;
            PG8_LDB(B1, 0, 1); PG8_STAGE(PG8_SB(0, 0), b2, voffB);
            PG8_BAR; PG8_WAIT_L(0); PG8_MMA(0, 1, At, B1); PG8_BAR;
            PG8_LDA(At, 0, 1); PG8_STAGE(PG8_SA(0, 0), a2, voffA);
            PG8_BAR; PG8_WAIT_L(0); PG8_MMA(1, 0, At, B0); PG8_BAR; PG8_SCHED;
            PG8_STAGE(PG8_SB(0, 1), b2 + hstep, voffB);
            PG8_WAIT_V(6); PG8_BAR; PG8_MMA(1, 1, At, B1); PG8_BAR;
            PG8_LDB(B0, 1, 0); PG8_SCHED; PG8_LDA(At, 1, 0); PG8_STAGE(PG8_SA(0, 1), a2 + hstep, voffA);
            PG8_WAIT_L(8); PG8_BAR; PG8_WAIT_L(0); PG8_MMA(0, 0, At, B0); PG8_BAR; PG8_SCHED;
            PG8_LDB(B1, 1, 1); PG8_STAGE(PG8_SB(1, 0), b3, voffB);
            PG8_BAR; PG8_WAIT_L(0); PG8_MMA(0, 1, At, B1); PG8_BAR;
            PG8_LDA(At, 1, 1); PG8_STAGE(PG8_SA(1, 0), a3, voffA);
            PG8_BAR; PG8_WAIT_L(0); PG8_MMA(1, 0, At, B0); PG8_BAR; PG8_SCHED;
            PG8_STAGE(PG8_SB(1, 1), b3 + hstep, voffB);
            PG8_WAIT_V(6); PG8_BAR; PG8_MMA(1, 1, At, B1); PG8_BAR;
            }
        }
        if constexpr (ALIGN_EPI) { if (wr == 0) PG8_BAR; }
        if constexpr (!Epi::AFTER_DRAIN) { E(acc, cur, wr, wc, fr, fq); S.done(cur); }
        if (!has_next) break;
#pragma unroll
        for (int a = 0; a < 2; ++a)
#pragma unroll
            for (int b = 0; b < 2; ++b)
#pragma unroll
                for (int m = 0; m < 4; ++m)
#pragma unroll
                    for (int n = 0; n < 2; ++n) acc[a][b][m][n] = (f32x4){0.f, 0.f, 0.f, 0.f};
        cur = nxt; cA = nA; cB = nB; ++ui;
        if constexpr (ALIGN_EPI) { if (wr == 1) PG8_BAR; }
    }
    PG8_WAIT_V(0);
    if constexpr (!ALIGN_EPI) { if (wr == 0) PG8_BAR; }
    PG8_BAR;
    if constexpr (Epi::AFTER_DRAIN) { E.fused(acc, cur, wr, wc, fr, fq, lds, wid, lane); S.done(cur); }
#undef PG8_SA
#undef PG8_SB
#undef PG8_STAGE
#undef PG8_LDA
#undef PG8_LDB
#undef PG8_MMA
#undef PG8_WAIT_V
#undef PG8_WAIT_L
#undef PG8_BAR
#undef PG8_SCHED
}
}

namespace cg = cooperative_groups;
#define LAS __attribute__((address_space(3)))
typedef unsigned short bf16;
typedef float f32x4 __attribute__((ext_vector_type(4)));
typedef float f32x16 __attribute__((ext_vector_type(16)));
typedef short bf16x8 __attribute__((ext_vector_type(8)));
typedef short s16x4 __attribute__((ext_vector_type(4)));
typedef unsigned u32x4 __attribute__((ext_vector_type(4)));
typedef unsigned u32x2 __attribute__((ext_vector_type(2)));
typedef float f32x2 __attribute__((ext_vector_type(2)));

#ifndef MK_PER_PHASE
#define MK_PER_PHASE 0
#endif

constexpr int NB = 16, SEQ = 2048, DM = 1024, MROWS = NB * SEQ, DFF = 2816, NMIX = 2816  , NMOD = 9216;
constexpr float ALPHA_C = 1.4142135623730951f, LN_EPS_C = 1e-5f, RMS_EPS_C = 1e-6f, LOG2E = 1.4426950408889634f;
constexpr int PC_AQ = 0, PC_AF = 256, PC_AI = 512, PC_AG = 768, PC_BCQ = 1024, PC_BCKV = 1280, PC_BKR = 1408, PC_CQ = 1440, PC_CK = 1696, PC_CV = 1952, PC_DU = 2208, PC_DV = 2464, PC_CF = 2720;

constexpr size_t MiB = 1u << 20;
constexpr size_t WS_CTL = 0, WS_MOD = 1 * MiB, WS_ROPE = 3 * MiB, WS_FNEG = 3 * MiB + 512 * 1024;
constexpr size_t WS_WIN = 4 * MiB, WIN_SZ = 11 * MiB;
constexpr size_t WS_WOUT = 48 * MiB, WOUT_SZ = 5 * MiB + 512 * 1024;
constexpr size_t WS_WMIX = 70 * MiB, WMIX_SZ = 5 * MiB + 512 * 1024;
constexpr size_t WS_WMO = 81 * MiB, WMO_SZ = 2 * MiB;
constexpr size_t WS_WUQ = 85 * MiB, WUQ_SZ = 256 * 1024, WS_WUKV = 85 * MiB + 512 * 1024, WUKV_SZ = 128 * 1024;
constexpr size_t WS_H = 86 * MiB, WS_HID = 150 * MiB, WS_CAT = 326 * MiB, WS_QM = 390 * MiB, WS_KM = 414 * MiB, WS_VM = 438 * MiB, WS_CQN = 454 * MiB, WS_CKVN = 470 * MiB, WS_END = 496 * MiB;
constexpr int RING_BYTES = 131072, MISC_OFF = RING_BYTES + 320, LDS_BYTES = 147456;
constexpr int NPHASE = 28;

struct Args {
    const float* in[23]; float* out; unsigned char* ws; int ph_lo, ph_hi;
};
typedef const __attribute__((address_space(4))) Args* ArgsP;
__device__ __forceinline__ ArgsP launder(ArgsP p) { asm volatile("" : "+s"(p)); return p; }

__device__ __forceinline__ float wave_sum(float v) {
#pragma unroll
    for (int o = 1; o < 64; o <<= 1) v += __shfl_xor(v, o);
    return v;
}
__device__ __forceinline__ float bf2f(unsigned short b) { return __uint_as_float((unsigned)b << 16); }
__device__ __forceinline__ float bflo(unsigned u) { return __uint_as_float(u << 16); }
__device__ __forceinline__ float bfhi(unsigned u) { return __uint_as_float(u & 0xffff0000u); }
__device__ __forceinline__ unsigned pk_bf16(float lo, float hi) { return pg8::cvt_pk_bf16(lo, hi); }
__device__ __forceinline__ float silu_x(float x) { return x / (1.0f + __expf(-x)); }
__device__ __forceinline__ float gelu_tanh(float x) { const float y = 0.7978845608028654f * (x + 0.044715f * x * x * x); const float e = __expf(2.0f * y); const float th = 1.0f - 2.0f / (e + 1.0f); return 0.5f * x * (1.0f + th); }
#define LDS_FENCE() asm volatile("s_waitcnt lgkmcnt(0)" ::: "memory")

__device__ __forceinline__ void tr_item(const float* __restrict__ W, int K, int N, int k0, int ns, int nvalid, bf16* WT, int nd, LAS float* scr, int lane) {
    const int nn = lane & 31;
#pragma unroll 8
    for (int i = 0; i < 32; ++i) { const int kk = 2 * i + (lane >> 5); scr[kk * 33 + nn] = (nn < nvalid) ? W[(size_t)(k0 + kk) * N + ns + nn] : 0.f; }
    LDS_FENCE();
    const int c = lane & 7;
#pragma unroll
    for (int j = 0; j < 4; ++j) { const int n = (lane >> 3) + 8 * j; const LAS float* s = scr + (8 * c) * 33 + n;
        u32x4 o; o.x = pk_bf16(s[0 * 33], s[1 * 33]); o.y = pk_bf16(s[2 * 33], s[3 * 33]); o.z = pk_bf16(s[4 * 33], s[5 * 33]); o.w = pk_bf16(s[6 * 33], s[7 * 33]);
        *(u32x4*)(WT + (size_t)(nd + n) * K + k0 + 8 * c) = o; }
    LDS_FENCE();
}

__device__ __forceinline__ void p0_prologue(ArgsP ap, LAS unsigned char* lds) {
    const int tid = tid_l(), lane = tid & 63, wave = __builtin_amdgcn_readfirstlane(tid >> 6);
    unsigned char* ws = ap->ws;
    {
        LAS float* scr = (LAS float*)(lds + wave * 16384);
        const int gw = bid_l() * 8 + wave, NGW = gdim_l() * 8;
        constexpr int I_IN = 16 * 176, I_OUT = 44 * 32, I_MIX = 16 * 88, I_MO = 16 * 32, I_UQ = 4 * 16, I_UKV = 2 * 16;
        constexpr int PER_L = 2 * I_IN + 2 * I_OUT + I_MIX + I_MO + I_UQ + I_UKV;
        for (int it = gw; it < 2 * PER_L; it += NGW) {
            const int l = it / PER_L; int r = it % PER_L;
            if (r < 2 * I_IN) { const int f = r / I_IN; r %= I_IN; const int kb = r / 176, db = r % 176, pn = db >> 3, q = db & 7;
                const float* W = ap->in[f ? 8 : 6] + (size_t)l * 1024 * 5632; const int ns = (q < 4) ? (128 * pn + 32 * q) : (2816 + 128 * pn + 32 * (q - 4));
                tr_item(W, 1024, 5632, 64 * kb, ns, 32, (bf16*)(ws + WS_WIN + (size_t)(f * 2 + l) * WIN_SZ), 32 * db, scr, lane); continue; }
            r -= 2 * I_IN;
            if (r < 2 * I_OUT) { const int f = r / I_OUT; r %= I_OUT; const int kb = r / 32, db = r % 32;
                const float* W = ap->in[f ? 9 : 7] + (size_t)l * 2816 * 1024;
                tr_item(W, 2816, 1024, 64 * kb, 32 * db, 32, (bf16*)(ws + WS_WOUT + (size_t)(f * 2 + l) * WOUT_SZ), 32 * db, scr, lane); continue; }
            r -= 2 * I_OUT;
            if (r < I_MIX) { const int kb = r / 88, db = r % 88; int ns, nv;
                if (db < 69) { ns = 32 * db; nv = 32; } else if (db < 85) { ns = 2212 + 32 * (db - 69); nv = 32; } else if (db == 85) { ns = 2208; nv = 4; } else { ns = 0; nv = 0; }
                const float* W = ap->in[10] + (size_t)l * 1024 * 2724;
                tr_item(W, 1024, 2724, 64 * kb, ns, nv, (bf16*)(ws + WS_WMIX + (size_t)l * WMIX_SZ), 32 * db, scr, lane); continue; }
            r -= I_MIX;
            if (r < I_MO) { const int kb = r / 32, db = r % 32;
                tr_item(ap->in[11] + (size_t)l * 1024 * 1024, 1024, 1024, 64 * kb, 32 * db, 32, (bf16*)(ws + WS_WMO + (size_t)l * WMO_SZ), 32 * db, scr, lane); continue; }
            r -= I_MO;
            if (r < I_UQ) { const int kb = r / 16, db = r % 16;
                tr_item(ap->in[16] + (size_t)l * 256 * 384, 256, 384, 64 * kb, 32 * db, db < 12 ? 32 : 0, (bf16*)(ws + WS_WUQ + (size_t)l * WUQ_SZ), 32 * db, scr, lane); continue; }
            r -= I_UQ;
            { const int kb = r / 16, db = r % 16;
                tr_item(ap->in[17] + (size_t)l * 128 * 512, 128, 512, 64 * kb, 32 * db, 32, (bf16*)(ws + WS_WUKV + (size_t)l * WUKV_SZ), 32 * db, scr, lane); }
        }
    }
    {
        float* rope = (float*)(ws + WS_ROPE);
        for (int i = bid_l() * 512 + tid; i < 2048 * 16; i += gdim_l() * 512) { const int pos = i >> 4, j = i & 15;
            const float invf = exp2f(-(float)j * (13.287712379549449f / 16.0f));
            const float ang = (float)pos * invf;
            const double rev = (double)ang * 0.15915494309189535; const float fr = (float)(rev - floor(rev));
            rope[2 * i] = __builtin_amdgcn_cosf(fr); rope[2 * i + 1] = __builtin_amdgcn_sinf(fr); }
    }
    __syncthreads();
    {
        LAS float* cact = (LAS float*)lds;
        LAS float* red = (LAS float*)(lds + 65536);
        const float* c = ap->in[1];
        for (int i = tid; i < 16 * 1024; i += 512) { const int b = i >> 10, k = i & 1023; cact[k * 16 + b] = silu_x(c[i]); }
        __syncthreads();
        float* mod = (float*)(ws + WS_MOD);
        for (int u = bid_l(); u < 2 * 144; u += gdim_l()) {
            const int l = u / 144, n = (u % 144) * 64 + lane;
            const float* wp = ap->in[2] + (size_t)l * 1024 * NMOD + (size_t)(wave * 128) * NMOD + n;
            float acc[16];
#pragma unroll
            for (int b = 0; b < 16; ++b) acc[b] = 0.f;
#pragma unroll 4
            for (int k = 0; k < 128; ++k) { const float wv = wp[(size_t)k * NMOD]; const LAS f32x4* cp = (const LAS f32x4*)(cact + (wave * 128 + k) * 16);
#pragma unroll
                for (int q = 0; q < 4; ++q) { const f32x4 cv = cp[q]; acc[4 * q] += cv[0] * wv; acc[4 * q + 1] += cv[1] * wv; acc[4 * q + 2] += cv[2] * wv; acc[4 * q + 3] += cv[3] * wv; } }
#pragma unroll
            for (int b = 0; b < 16; ++b) red[(wave * 16 + b) * 64 + lane] = acc[b];
            __syncthreads();
            for (int o = tid; o < 16 * 64; o += 512) { const int b = o >> 6, ln = o & 63; float s = 0.f;
#pragma unroll
                for (int w = 0; w < 8; ++w) s += red[(w * 16 + b) * 64 + ln];
                const int nn = (u % 144) * 64 + ln; mod[((size_t)l * 16 + b) * NMOD + nn] = s + ap->in[3][(size_t)l * NMOD + nn]; }
            __syncthreads();
        }
    }
}

__device__ __forceinline__ void ln_phase(const float* xin, float* X, bf16* H, const float* g, const float* bta, const float* sh, const float* sc, bool do_ln) {
    const int tid = tid_l(), lane = tid & 63, wave = tid >> 6;
    const int gw = bid_l() * 8 + wave, NGW = gdim_l() * 8;
    for (int row = gw; row < MROWS; row += NGW) {
        const f32x4* xr = (const f32x4*)((do_ln ? X : xin) + (size_t)row * DM) + lane;
        f32x4 v[4];
#pragma unroll
        for (int j = 0; j < 4; ++j) v[j] = xr[64 * j];
        if (do_ln) {
            float s = 0.f;
#pragma unroll
            for (int j = 0; j < 4; ++j) s += (v[j][0] + v[j][1]) + (v[j][2] + v[j][3]);
            const float mean = wave_sum(s) * (1.f / DM); float s2 = 0.f;
#pragma unroll
            for (int j = 0; j < 4; ++j) { v[j] = v[j] - mean; s2 += (v[j][0] * v[j][0] + v[j][1] * v[j][1]) + (v[j][2] * v[j][2] + v[j][3] * v[j][3]); }
            const float rstd = 1.f / sqrtf(wave_sum(s2) * (1.f / DM) + LN_EPS_C);
#pragma unroll
            for (int j = 0; j < 4; ++j) { const f32x4 gv = ((const f32x4*)g)[lane + 64 * j], bv = ((const f32x4*)bta)[lane + 64 * j]; v[j] = v[j] * rstd * gv + bv; }
        }
        f32x4* xo = (f32x4*)(X + (size_t)row * DM) + lane;
#pragma unroll
        for (int j = 0; j < 4; ++j) xo[64 * j] = v[j];
        if (H) {
            const int b = row >> 11; const f32x4* shp = (const f32x4*)(sh + (size_t)b * NMOD) + lane; const f32x4* scp = (const f32x4*)(sc + (size_t)b * NMOD) + lane;
            u32x2* ho = (u32x2*)(H + (size_t)row * DM) + lane;
#pragma unroll
            for (int j = 0; j < 4; ++j) { const f32x4 hv = v[j] * (scp[64 * j] + 1.0f) + shp[64 * j]; u32x2 w; w.x = pk_bf16(hv[0], hv[1]); w.y = pk_bf16(hv[2], hv[3]); ho[64 * j] = w; }
        }
    }
}

__device__ __forceinline__ void prep_phase(const bf16* PROJ, bf16* CQN, bf16* CKVN, bf16* KM, float* FNEG, const float* rope, const float* qg, const float* kvg, const float* fox_b) {
    const int tid = tid_l(), lane = tid & 63, wave = tid >> 6;
    const int gw = bid_l() * 8 + wave, NGW = gdim_l() * 8;
    if (gw < 64) {
        const int b = gw >> 2, h = gw & 3; const float bf_ = fox_b[h]; float carry = 0.f;
        for (int i = 0; i < 32; ++i) { const int s = 64 * i + lane; const size_t row = (size_t)b * SEQ + s;
            const float z = bf2f(PROJ[row * NMIX + PC_CF + h]) + bf_;
            float v = fminf(z, 0.f) - log1pf(__expf(-fabsf(z)));
#pragma unroll
            for (int o = 1; o < 64; o <<= 1) { const float t = __shfl_up(v, o); if (lane >= o) v += t; }
            v += carry; carry = __shfl(v, 63);
            FNEG[row * 4 + h] = -LOG2E * v; }
    }
    for (int row = gw; row < MROWS; row += NGW) {
        const bf16* p = PROJ + (size_t)row * NMIX;
        {
            const u32x2 u = *(const u32x2*)(p + PC_BCQ + 4 * lane); const float a0 = bflo(u.x), a1 = bfhi(u.x), a2 = bflo(u.y), a3 = bfhi(u.y);
            const float r = 1.f / sqrtf(wave_sum(a0 * a0 + a1 * a1 + a2 * a2 + a3 * a3) * (1.f / 256) + RMS_EPS_C); const f32x4 gv = ((const f32x4*)qg)[lane];
            u32x2 w; w.x = pk_bf16(a0 * r * gv[0], a1 * r * gv[1]); w.y = pk_bf16(a2 * r * gv[2], a3 * r * gv[3]); *(u32x2*)(CQN + (size_t)row * 256 + 4 * lane) = w; }
        {
            const unsigned u = *(const unsigned*)(p + PC_BCKV + 2 * lane); const float a0 = bflo(u), a1 = bfhi(u);
            const float r = 1.f / sqrtf(wave_sum(a0 * a0 + a1 * a1) * (1.f / 128) + RMS_EPS_C);
            *(unsigned*)(CKVN + (size_t)row * 128 + 2 * lane) = pk_bf16(a0 * r * kvg[2 * lane], a1 * r * kvg[2 * lane + 1]); }
        {
            const int j = lane & 15, h = lane >> 4; const float x1 = bf2f(p[PC_BKR + j]), x2 = bf2f(p[PC_BKR + 16 + j]);
            const float c = rope[((size_t)(row & 2047) * 16 + j) * 2], s = rope[((size_t)(row & 2047) * 16 + j) * 2 + 1];
            bf16* kp = KM + (size_t)row * 384 + 96 * h + 64 + j;
            kp[0] = (bf16)(pk_bf16(x1 * c - x2 * s, 0.f) & 0xffffu); kp[16] = (bf16)(pk_bf16(x1 * s + x2 * c, 0.f) & 0xffffu); }
    }
}

constexpr int AT_KCH = 1040, AT_KOFF = 0, AT_VOFF = 12544, AT_BOFF = AT_VOFF + 8192, AT_WOFF = AT_BOFF + 256;
__device__ __forceinline__ s16x4 vtr(const LAS unsigned char* p) { typedef short v4i16_t __attribute__((ext_vector_type(4))); return __builtin_bit_cast(s16x4, __builtin_amdgcn_ds_read_tr16_b64_v4i16((LAS v4i16_t*)p)); }
__device__ __forceinline__ int crow(int r, int hi) { return (r & 3) + 8 * (r >> 2) + 4 * hi; }
template <int DK, bool BIAS, bool ROPE>
__device__ __forceinline__ void attn_unit(LAS unsigned char* lds, const bf16* Qp, int ldq, const bf16* Kp, int ldk, const bf16* Vp, int ldv, const float* biasp, const float* rope, float sc, bf16* Op, int b, int qb) {
    constexpr int NC = DK / 8, NCH = 64 * NC;
    const int tid = tid_l(), lane = tid & 63, w = __builtin_amdgcn_readfirstlane(tid >> 6), r32 = lane & 31, hi = lane >> 5;
    const size_t rowbase = (size_t)b * SEQ; const int q0 = 256 * qb + 32 * w;
    bf16x8 qf[DK / 16];
    { const bf16* qrow = Qp + (rowbase + q0 + r32) * ldq + 8 * hi;
#pragma unroll
      for (int d0 = 0; d0 < DK / 16; ++d0) qf[d0] = *(const bf16x8*)(qrow + 16 * d0); }
    if (ROPE) {
        const f32x4* rp = (const f32x4*)(rope + ((size_t)(q0 + r32) * 16 + 8 * hi) * 2);
        bf16x8 a = qf[DK / 16 - 2], c = qf[DK / 16 - 1];
#pragma unroll
        for (int e2 = 0; e2 < 4; ++e2) { const f32x4 cs = rp[e2];
            const float x1a = bf2f((unsigned short)a[2 * e2]), x2a = bf2f((unsigned short)c[2 * e2]), x1b = bf2f((unsigned short)a[2 * e2 + 1]), x2b = bf2f((unsigned short)c[2 * e2 + 1]);
            const unsigned n1 = pk_bf16(x1a * cs[0] - x2a * cs[1], x1b * cs[2] - x2b * cs[3]), n2 = pk_bf16(x1a * cs[1] + x2a * cs[0], x1b * cs[3] + x2b * cs[2]);
            a[2 * e2] = (short)(n1 & 0xffffu); a[2 * e2 + 1] = (short)(n1 >> 16); c[2 * e2] = (short)(n2 & 0xffffu); c[2 * e2 + 1] = (short)(n2 >> 16); }
        qf[DK / 16 - 2] = a; qf[DK / 16 - 1] = c;
    }
    f32x16 o0, o1;
#pragma unroll
    for (int r = 0; r < 16; ++r) { o0[r] = 0.f; o1[r] = 0.f; }
    float m_run = -INFINITY, l_run = 0.f;
    const int NT = 4 * (qb + 1), tmax_w = 4 * qb + (w >> 1);
    LAS float* wsf = (LAS float*)(lds + AT_WOFF) + w * 64; const LAS float* biasL = (const LAS float*)(lds + AT_BOFF);
    const int kc0 = tid, kv0 = kc0 / NC, c0 = kc0 % NC; const int kc1 = tid + 512, kv1 = kc1 / NC, c1 = kc1 % NC; const bool has1 = kc1 < NCH;
    const int vkv = tid >> 3, vc = tid & 7;
    u32x4 kr0, kr1 = {0u, 0u, 0u, 0u}, vr; float br = 0.f;
#define AT_LOAD(t) do { const size_t rb_ = rowbase + 64 * (size_t)(t); \
        kr0 = *(const u32x4*)(Kp + (rb_ + kv0) * ldk + 8 * c0); if (has1) kr1 = *(const u32x4*)(Kp + (rb_ + kv1) * ldk + 8 * c1); \
        vr = *(const u32x4*)(Vp + (rb_ + vkv) * ldv + 8 * vc); if (BIAS && tid < 64) br = biasp[(rb_ + tid) * 4]; } while (0)
    AT_LOAD(0);
    for (int t = 0; t < NT; ++t) {
        __syncthreads();
        *(LAS u32x4*)(lds + AT_KOFF + c0 * AT_KCH + kv0 * 16) = kr0; if (has1) *(LAS u32x4*)(lds + AT_KOFF + c1 * AT_KCH + kv1 * 16) = kr1;
        *(LAS u32x4*)(lds + AT_VOFF + (vc >> 2) * 4096 + vkv * 64 + (vc & 3) * 16) = vr; if (BIAS && tid < 64) ((LAS float*)(lds + AT_BOFF))[tid] = br;
        __syncthreads();
        if (t + 1 < NT) AT_LOAD(t + 1);
        if (t <= tmax_w) {
            f32x16 p0, p1;
#pragma unroll
            for (int r = 0; r < 16; ++r) { p0[r] = 0.f; p1[r] = 0.f; }
#pragma unroll
            for (int d0 = 0; d0 < DK / 16; ++d0) { const LAS unsigned char* kb = lds + AT_KOFF + (2 * d0 + hi) * AT_KCH + r32 * 16;
                const bf16x8 k0 = *(const LAS bf16x8*)kb, k1 = *(const LAS bf16x8*)(kb + 512);
                p0 = __builtin_amdgcn_mfma_f32_32x32x16_bf16(k0, qf[d0], p0, 0, 0, 0); p1 = __builtin_amdgcn_mfma_f32_32x32x16_bf16(k1, qf[d0], p1, 0, 0, 0); }
#pragma unroll
            for (int g = 0; g < 4; ++g) { f32x4 b0 = {0.f, 0.f, 0.f, 0.f}, b1 = {0.f, 0.f, 0.f, 0.f};
                if (BIAS) { b0 = *(const LAS f32x4*)(biasL + 8 * g + 4 * hi); b1 = *(const LAS f32x4*)(biasL + 32 + 8 * g + 4 * hi); }
#pragma unroll
                for (int i = 0; i < 4; ++i) { p0[4 * g + i] = p0[4 * g + i] * sc + b0[i]; p1[4 * g + i] = p1[4 * g + i] * sc + b1[i]; } }
            if (64 * t + 63 > q0) { const int qg = q0 + r32;
#pragma unroll
                for (int r = 0; r < 16; ++r) { const int kvg = 64 * t + crow(r, hi); if (kvg > qg) p0[r] = -INFINITY; if (kvg + 32 > qg) p1[r] = -INFINITY; } }
            float mt = fmaxf(p0[0], p1[0]);
#pragma unroll
            for (int r = 1; r < 16; ++r) mt = fmaxf(mt, fmaxf(p0[r], p1[r]));
            mt = fmaxf(mt, __shfl_xor(mt, 32));
            const float m_new = fmaxf(m_run, mt), alpha = __builtin_amdgcn_exp2f(m_run - m_new); m_run = m_new;
            float ls = 0.f;
#pragma unroll
            for (int r = 0; r < 16; ++r) { p0[r] = __builtin_amdgcn_exp2f(p0[r] - m_new); p1[r] = __builtin_amdgcn_exp2f(p1[r] - m_new); ls += p0[r] + p1[r]; }
            l_run = l_run * alpha + ls;
            if (hi == 0) wsf[r32] = alpha;
            LDS_FENCE();
#pragma unroll
            for (int g = 0; g < 4; ++g) { const f32x4 av = *(const LAS f32x4*)(wsf + 8 * g + 4 * hi);
#pragma unroll
                for (int i = 0; i < 4; ++i) { o0[4 * g + i] *= av[i]; o1[4 * g + i] *= av[i]; } }
            u32x4 pw[4];
#pragma unroll
            for (int k = 0; k < 2; ++k) {
                pw[k] = (u32x4){pk_bf16(p0[8 * k], p0[8 * k + 1]), pk_bf16(p0[8 * k + 2], p0[8 * k + 3]), pk_bf16(p0[8 * k + 4], p0[8 * k + 5]), pk_bf16(p0[8 * k + 6], p0[8 * k + 7])};
                pw[2 + k] = (u32x4){pk_bf16(p1[8 * k], p1[8 * k + 1]), pk_bf16(p1[8 * k + 2], p1[8 * k + 3]), pk_bf16(p1[8 * k + 4], p1[8 * k + 5]), pk_bf16(p1[8 * k + 6], p1[8 * k + 7])}; }
            const LAS unsigned char* vb = lds + AT_VOFF + ((lane >> 4) & 1) * 32 + (lane & 3) * 8 + (4 * hi + ((lane & 15) >> 2)) * 64;
#pragma unroll
            for (int ks = 0; ks < 4; ++ks) {
                const s16x4 l0 = vtr(vb + ks * 1024), h0 = vtr(vb + ks * 1024 + 512), l1 = vtr(vb + 4096 + ks * 1024), h1 = vtr(vb + 4096 + ks * 1024 + 512);
                const bf16x8 v0 = {l0[0], l0[1], l0[2], l0[3], h0[0], h0[1], h0[2], h0[3]}, v1 = {l1[0], l1[1], l1[2], l1[3], h1[0], h1[1], h1[2], h1[3]};
                const bf16x8 pa = __builtin_bit_cast(bf16x8, pw[ks]);
                o0 = __builtin_amdgcn_mfma_f32_32x32x16_bf16(pa, v0, o0, 0, 0, 0); o1 = __builtin_amdgcn_mfma_f32_32x32x16_bf16(pa, v1, o1, 0, 0, 0); }
            LDS_FENCE();
        }
    }
#undef AT_LOAD
    l_run += __shfl_xor(l_run, 32);
    if (hi == 0) wsf[32 + r32] = 1.0f / l_run;
    LDS_FENCE();
#pragma unroll
    for (int g = 0; g < 4; ++g) { const f32x4 rv = *(const LAS f32x4*)(wsf + 32 + 8 * g + 4 * hi);
#pragma unroll
        for (int i = 0; i < 4; ++i) { bf16* op = Op + (rowbase + q0 + 8 * g + 4 * hi + i) * 1024 + r32;
            op[0] = (bf16)(pk_bf16(o0[4 * g + i] * rv[i], 0.f) & 0xffffu); op[32] = (bf16)(pk_bf16(o1[4 * g + i] * rv[i], 0.f) & 0xffffu); } }
    LDS_FENCE();
    __syncthreads();
}

constexpr size_t WS_OLOC = WS_H, WS_QDC = WS_H + 32 * MiB, WS_SST = 478 * MiB, WS_SDEC = 494 * MiB;
constexpr int HP = 68;
__device__ __forceinline__ void hgrnA_unit(LAS unsigned char* lds, const bf16* PROJ, float* OLOC, float* QDC, float* SST, float* SDEC, const float* lb_logits, int l, int b, int h, int sc) {
    LAS float* F = (LAS float*)lds;
    LAS float *QF = F, *KK = F + 1088, *GA = F + 2176, *LF = F + 3264, *QD = F + 4352, *KE = F + 5376, *DEC = F + 6400, *VV = F + 6464, *SC = F + 7488, *PI = F + 7760;
    const int tid = tid_l(), lane = tid & 63, w = __builtin_amdgcn_readfirstlane(tid >> 6);
    const int t1 = tid >> 5, a1 = 2 * (tid & 31);
    float lbm[2], oml[2], gbase[2] = {0.f, 0.f};
#pragma unroll
    for (int e = 0; e < 2; ++e) { float lbv = 0.f; if (l == 1) { const float z0 = lb_logits[64 * h + a1 + e], z1 = lb_logits[256 + 64 * h + a1 + e]; lbv = 1.0f / (1.0f + __expf(z0 - z1)); }
        lbm[e] = fmaxf(lbv, 1e-30f); oml[e] = 1.0f - lbv; }
    float st[8];
#pragma unroll
    for (int j = 0; j < 8; ++j) st[j] = 0.f;
    const size_t rs = (size_t)b * SEQ + 128 * sc;
    for (int c = 0; c < 8; ++c) {
        const size_t r0 = rs + 16 * c;
        {
            const bf16* prow = PROJ + (r0 + t1) * NMIX + 64 * h + a1;
            const unsigned uq = *(const unsigned*)(prow + PC_AQ), uf = *(const unsigned*)(prow + PC_AF), ui = *(const unsigned*)(prow + PC_AI);
            float qv[2], lv[2], kv[2];
#pragma unroll
            for (int e = 0; e < 2; ++e) { const float q = e ? bfhi(uq) : bflo(uq), z = e ? bfhi(uf) : bflo(uf);
                const float ez = __expf(-fabsf(z)), rb = __builtin_amdgcn_rcpf(1.0f + ez), sbig = rb, ssm = ez * rb; const float sg = z >= 0.f ? sbig : ssm, nsg = z >= 0.f ? ssm : sbig;
                qv[e] = silu_x(q); lv[e] = __log2f(lbm[e] + oml[e] * sg); kv[e] = oml[e] * nsg; }
            *(LAS f32x2*)(QF + t1 * HP + a1) = (f32x2){qv[0], qv[1]}; *(LAS f32x2*)(LF + t1 * HP + a1) = (f32x2){lv[0], lv[1]}; *(LAS f32x2*)(KK + t1 * HP + a1) = (f32x2){kv[0], kv[1]};
            *(LAS f32x2*)(VV + t1 * 64 + a1) = (f32x2){bflo(ui), bfhi(ui)};
        }
        __syncthreads();
        {
            float qdc[2];
#pragma unroll
            for (int e = 0; e < 2; ++e) { const int a = a1 + e; float pre = 0.f, tot = 0.f;
#pragma unroll
                for (int tt = 0; tt < 16; ++tt) { const float x = LF[tt * HP + a]; tot += x; if (tt <= t1) pre += x; }
                const float qf = QF[t1 * HP + a];
                GA[t1 * HP + a] = pre; QD[t1 * 64 + a] = qf * __builtin_amdgcn_exp2f(pre); KE[t1 * 64 + a] = KK[t1 * HP + a] * __builtin_amdgcn_exp2f(tot - pre); if (t1 == 15) DEC[a] = __builtin_amdgcn_exp2f(tot);
                qdc[e] = qf * __builtin_amdgcn_exp2f(pre + gbase[e]); gbase[e] += tot; }
            *(f32x2*)(QDC + (r0 + t1) * 256 + 64 * h + a1) = (f32x2){qdc[0], qdc[1]};
        }
        __syncthreads();
        {
#pragma unroll 4
            for (int tt = 0; tt < 16; ++tt) { const f32x4 qa = *(const LAS f32x4*)(QD + tt * 64 + 8 * w), qb_ = *(const LAS f32x4*)(QD + tt * 64 + 8 * w + 4);
                PI[(w * 16 + tt) * 64 + lane] = (qa[0] * st[0] + qa[1] * st[1]) + (qa[2] * st[2] + qa[3] * st[3]) + (qb_[0] * st[4] + qb_[1] * st[5]) + (qb_[2] * st[6] + qb_[3] * st[7]); }
            { const f32x4 da = *(const LAS f32x4*)(DEC + 8 * w), db = *(const LAS f32x4*)(DEC + 8 * w + 4);
              st[0] *= da[0]; st[1] *= da[1]; st[2] *= da[2]; st[3] *= da[3]; st[4] *= db[0]; st[5] *= db[1]; st[6] *= db[2]; st[7] *= db[3]; }
#pragma unroll 4
            for (int s = 0; s < 16; ++s) { const float vv = VV[s * 64 + lane]; const f32x4 ka = *(const LAS f32x4*)(KE + s * 64 + 8 * w), kb = *(const LAS f32x4*)(KE + s * 64 + 8 * w + 4);
                st[0] += ka[0] * vv; st[1] += ka[1] * vv; st[2] += ka[2] * vv; st[3] += ka[3] * vv; st[4] += kb[0] * vv; st[5] += kb[1] * vv; st[6] += kb[2] * vv; st[7] += kb[3] * vv; }
            const int p = tid >> 1, half = tid & 1, tq = p >> 4, sk = p & 15; float val = 0.f;
            if (sk <= tq) {
#pragma unroll
                for (int a4 = 0; a4 < 8; ++a4) { const int a = 32 * half + 4 * a4;
                    const f32x4 q4 = *(const LAS f32x4*)(QF + tq * HP + a), k4 = *(const LAS f32x4*)(KK + sk * HP + a), gt = *(const LAS f32x4*)(GA + tq * HP + a), gs = *(const LAS f32x4*)(GA + sk * HP + a);
#pragma unroll
                    for (int i = 0; i < 4; ++i) val += q4[i] * k4[i] * __builtin_amdgcn_exp2f(gt[i] - gs[i]); } }
            val += __shfl_xor(val, 1);
            if (half == 0) SC[tq * 17 + sk] = val;
        }
        __syncthreads();
        {
            float o[2];
#pragma unroll
            for (int e = 0; e < 2; ++e) { const int v = a1 + e; float s = 0.f;
#pragma unroll
                for (int ww = 0; ww < 8; ++ww) s += PI[(ww * 16 + t1) * 64 + v];
                for (int sk = 0; sk <= t1; ++sk) s += SC[t1 * 17 + sk] * VV[sk * 64 + v];
                o[e] = s; }
            *(f32x2*)(OLOC + (r0 + t1) * 256 + 64 * h + a1) = (f32x2){o[0], o[1]};
        }
        __syncthreads();
    }
    const size_t u = ((size_t)(b * 4 + h) * 16 + sc);
#pragma unroll
    for (int j = 0; j < 8; ++j) SST[u * 4096 + (size_t)(8 * w + j) * 64 + lane] = st[j];
    if (t1 == 0) { SDEC[u * 64 + a1] = __builtin_amdgcn_exp2f(gbase[0]); SDEC[u * 64 + a1 + 1] = __builtin_amdgcn_exp2f(gbase[1]); }
}
__device__ __forceinline__ void hgrn_scan(float* SST, const float* SDEC) {
    const int g = bid_l() * 512 + tid_l(), NG = gdim_l() * 512;
    for (int idx = g; idx < 64 * 4096; idx += NG) { const int bh = idx >> 12, e = idx & 4095, a = e >> 6;
        float tv[16], dv[16];
#pragma unroll
        for (int sc = 0; sc < 16; ++sc) { tv[sc] = SST[((size_t)bh * 16 + sc) * 4096 + e]; dv[sc] = SDEC[((size_t)bh * 16 + sc) * 64 + a]; }
        float run = 0.f;
#pragma unroll
        for (int sc = 0; sc < 16; ++sc) { SST[((size_t)bh * 16 + sc) * 4096 + e] = run; run = dv[sc] * run + tv[sc]; } }
}
__device__ __forceinline__ void hgrnC_unit(LAS unsigned char* lds, const bf16* PROJ, bf16* CAT, const float* OLOC, const float* QDC, const float* SST, const float* norm_g, int b, int h, int sc) {
    LAS float* QL = (LAS float*)lds;
    const int tid = tid_l(), lane = tid & 63, w = __builtin_amdgcn_readfirstlane(tid >> 6);
    const size_t rs = (size_t)b * SEQ + 128 * sc;
    for (int i = tid; i < 128 * 16; i += 512) { const int t = i >> 4, a4 = i & 15; *(LAS f32x4*)(QL + t * 64 + 4 * a4) = *(const f32x4*)(QDC + (rs + t) * 256 + 64 * h + 4 * a4); }
    float sreg[64];
    const float* sp = SST + ((size_t)(b * 4 + h) * 16 + sc) * 4096 + lane;
#pragma unroll
    for (int a = 0; a < 64; ++a) sreg[a] = sp[a * 64];
    const float ng = norm_g[64 * h + lane];
    __syncthreads();
    for (int t = 16 * w; t < 16 * w + 16; ++t) { const size_t row = rs + t;
        float o = OLOC[row * 256 + 64 * h + lane];
#pragma unroll
        for (int a4 = 0; a4 < 16; ++a4) { const f32x4 q = *(const LAS f32x4*)(QL + t * 64 + 4 * a4); o += (q[0] * sreg[4 * a4] + q[1] * sreg[4 * a4 + 1]) + (q[2] * sreg[4 * a4 + 2] + q[3] * sreg[4 * a4 + 3]); }
        const float r = 1.f / sqrtf(wave_sum(o * o) * (1.f / 64) + RMS_EPS_C);
        const float gv = bf2f(PROJ[row * NMIX + PC_AG + 64 * h + lane]);
        CAT[row * 1024 + 64 * h + lane] = (bf16)(pk_bf16(o * r * ng * silu_x(gv), 0.f) & 0xffffu); }
    __syncthreads();
}

__device__ __forceinline__ void gmlp_unit(LAS unsigned char* lds, const bf16* PROJ, bf16* CAT, const float* lng, const float* lnb, const float* __restrict__ ws_, const float* bs, int b, int ci) {
    LAS float* VT = (LAS float*)lds;
    const int tid = tid_l(), lane = tid & 63, w = __builtin_amdgcn_readfirstlane(tid >> 6);
    const size_t r0 = (size_t)b * SEQ + 128 * ci;
    { const f32x4 gv = ((const f32x4*)lng)[lane], bv = ((const f32x4*)lnb)[lane];
      for (int tt = 16 * w; tt < 16 * w + 16; ++tt) { const u32x2 u = *(const u32x2*)(PROJ + (r0 + tt) * NMIX + PC_DV + 4 * lane);
        f32x4 x = {gelu_tanh(bflo(u.x)), gelu_tanh(bfhi(u.x)), gelu_tanh(bflo(u.y)), gelu_tanh(bfhi(u.y))};
        const float mean = wave_sum((x[0] + x[1]) + (x[2] + x[3])) * (1.f / 256); x = x - mean;
        const float rstd = 1.f / sqrtf(wave_sum((x[0] * x[0] + x[1] * x[1]) + (x[2] * x[2] + x[3] * x[3])) * (1.f / 256) + LN_EPS_C);
        *(LAS f32x4*)(VT + tt * 256 + 4 * lane) = x * rstd * gv + bv; } }
    __syncthreads();
    { const int c = tid & 255, th = w >> 2, g = w & 3; const float* wg = ws_ + (size_t)g * 128 * 128;
      for (int j = 0; j < 8; ++j) { const int tb = th + 16 * j; float acc[8];
#pragma unroll
        for (int i = 0; i < 8; ++i) acc[i] = 0.f;
        for (int s = 0; s <= tb + 14; ++s) { const float v = VT[s * 256 + c];
#pragma unroll
            for (int i = 0; i < 8; ++i) { const int ti = tb + 2 * i; const float wv = (s <= ti) ? wg[ti * 128 + s] : 0.f; acc[i] += wv * v; } }
#pragma unroll
        for (int i = 0; i < 8; ++i) { const int ti = tb + 2 * i; const float mixed = acc[i] + bs[g * 128 + ti];
            const float u = gelu_tanh(bf2f(PROJ[(r0 + ti) * NMIX + PC_DU + c]));
            CAT[(r0 + ti) * 1024 + 768 + c] = (bf16)(pk_bf16(u * mixed, 0.f) & 0xffffu); } } }
    __syncthreads();
}

__device__ __forceinline__ void mixer_phase(ArgsP ap0, LAS unsigned char* lds, int l) {
    volatile LAS int* slot = (volatile LAS int*)(lds + MISC_OFF);
    constexpr int NHC = 1024, NU = NHC + 1024 + 256;
    for (;;) {
        ArgsP ap = launder(ap0);
        unsigned char* ws = ap->ws; const bf16* PROJ = (const bf16*)(ws + WS_HID); bf16* CAT = (bf16*)(ws + WS_CAT);
        __syncthreads();
        if (tid_l() == 0) *slot = (int)atomicAdd((unsigned*)(ws + WS_CTL) + 64 * (1 + l), 1u);
        __syncthreads();
        const int u = __builtin_amdgcn_readfirstlane(*slot);
        if (u >= NU) break;
        if (u < NHC) { hgrnC_unit(lds, PROJ, CAT, (const float*)(ws + WS_OLOC), (const float*)(ws + WS_QDC), (const float*)(ws + WS_SST), ap->in[13] + l * 256, u >> 6, (u >> 4) & 3, u & 15); }
        else if (u < NHC + 1024) { const int ai = u - NHC, qb = 7 - (ai >> 7), rem = ai & 127, ty = rem & 1, bh = rem >> 1, b = bh >> 2, h = bh & 3;
            if (ty == 0) attn_unit<96, false, true>(lds, (const bf16*)(ws + WS_QM) + 96 * h, 384, (const bf16*)(ws + WS_KM) + 96 * h, 384, (const bf16*)(ws + WS_VM) + 64 * h, 256, nullptr, (const float*)(ws + WS_ROPE), 1.0f, CAT + 256 + 64 * h, b, qb);
            else attn_unit<64, true, false>(lds, PROJ + PC_CQ + 64 * h, NMIX, PROJ + PC_CK + 64 * h, NMIX, PROJ + PC_CV + 64 * h, NMIX, (const float*)(ws + WS_FNEG) + h, nullptr, 0.125f * LOG2E, CAT + 512 + 64 * h, b, qb); }
        else { const int gi = u - NHC - 1024; gmlp_unit(lds, PROJ, CAT, ap->in[19] + l * 256, ap->in[20] + l * 256, ap->in[21] + (size_t)l * 4 * 128 * 128, ap->in[22] + l * 512, gi >> 4, gi & 15); }
    }
}

__device__ __forceinline__ void run_phase(ArgsP ap0, LAS unsigned char* lds, int ph) {
    ArgsP ap = launder(ap0);
    unsigned char* ws = ap->ws; float* X = ap->out; float* mod = (float*)(ws + WS_MOD);
    bf16* H = (bf16*)(ws + WS_H); bf16* HID = (bf16*)(ws + WS_HID); bf16* CAT = (bf16*)(ws + WS_CAT);
    const int G = gdim_l(), bx = bid_l();
    if (ph == 0) { p0_prologue(ap, lds); return; }
    if (ph == 1) { ln_phase(ap->in[0], X, H, nullptr, nullptr, mod + 0 * 1024, mod + 1 * 1024, false); return; }
    const int l = (ph - 2) / 13, sp = (ph - 2) % 13; const float* modl = mod + (size_t)l * 16 * NMOD;
    if (sp == 0 || sp == 10) {
        const int f = sp == 10; pg8::Gemm g{H, (const bf16*)(ws + WS_WIN + (size_t)(f * 2 + l) * WIN_SZ), MROWS, 2 * DFF, DM}; pg8::StaticOrder S; S.init(MROWS, 2 * DFF, G, bx);
        pg8::EpiSwiGLU E{HID, DFF}; pg8::gemm_phase<pg8::EpiSwiGLU, pg8::StaticOrder, true, true>(lds, g, S, E);
    } else if (sp == 1 || sp == 11) {
        const int f = sp == 11; pg8::Gemm g{HID, (const bf16*)(ws + WS_WOUT + (size_t)(f * 2 + l) * WOUT_SZ), MROWS, DM, DFF}; pg8::StaticOrder S; S.init(MROWS, DM, G, bx);
        pg8::EpiResid E{X, modl + (f ? 8 : 2) * 1024, 0.5f, ALPHA_C}; pg8::gemm_phase<pg8::EpiResid, pg8::StaticOrder, true, true>(lds, g, S, E);
    } else if (sp == 2 || sp == 9 || sp == 12) {
        const int i = sp == 2 ? 0 : (sp == 9 ? 1 : 2); const float* g_ = ap->in[4] + (size_t)(l * 3 + i) * DM; const float* b_ = ap->in[5] + (size_t)(l * 3 + i) * DM;
        const bool last = (sp == 12 && l == 1); const float* mnext = (sp == 12) ? (mod + (size_t)(l + 1) * 16 * NMOD) : (modl + (size_t)(3 * (i + 1)) * 1024);
        ln_phase(nullptr, X, last ? nullptr : H, g_, b_, last ? nullptr : mnext, last ? nullptr : mnext + 1024, true);
    } else if (sp == 3) {
        pg8::Gemm g{H, (const bf16*)(ws + WS_WMIX + (size_t)l * WMIX_SZ), MROWS, NMIX, DM}; pg8::StaticOrder S; S.init(MROWS, NMIX, G, bx);
        pg8::EpiBf16<0> E{HID, NMIX, nullptr, 0, 0, 1.f}; pg8::gemm_phase<pg8::EpiBf16<0>, pg8::StaticOrder, true, true>(lds, g, S, E);
    } else if (sp == 4) {
        for (int u = bx; u < 1024; u += G) hgrnA_unit(lds, HID, (float*)(ws + WS_OLOC), (float*)(ws + WS_QDC), (float*)(ws + WS_SST), (float*)(ws + WS_SDEC), ap->in[12], l, u >> 6, (u >> 4) & 3, u & 15);
        prep_phase(HID, (bf16*)(ws + WS_CQN), (bf16*)(ws + WS_CKVN), (bf16*)(ws + WS_KM), (float*)(ws + WS_FNEG), (const float*)(ws + WS_ROPE), ap->in[14] + l * 256, ap->in[15] + l * 128, ap->in[18] + l * 4);
    } else if (sp == 5) {
        hgrn_scan((float*)(ws + WS_SST), (const float*)(ws + WS_SDEC));
        { pg8::Gemm g{(const bf16*)(ws + WS_CQN), (const bf16*)(ws + WS_WUQ + (size_t)l * WUQ_SZ), MROWS, 512, opaque_i(256)}; pg8::StaticOrder S; S.init(MROWS, 512, G, bx);
          pg8::EpiQup E{(bf16*)(ws + WS_QM), 0.10206207261596575f * LOG2E}; pg8::gemm_phase<pg8::EpiQup, pg8::StaticOrder, true, true>(lds, g, S, E); }
    } else if (sp == 6) {
        { pg8::Gemm g{(const bf16*)(ws + WS_CKVN), (const bf16*)(ws + WS_WUKV + (size_t)l * WUKV_SZ), MROWS, 512, opaque_i(128)}; pg8::StaticOrder S; S.init(MROWS, 512, G, bx);
          pg8::EpiKVup E{(bf16*)(ws + WS_KM), (bf16*)(ws + WS_VM)}; pg8::gemm_phase<pg8::EpiKVup, pg8::StaticOrder, true, true>(lds, g, S, E); }
    } else if (sp == 7) {
        mixer_phase(ap0, lds, l);
    } else if (sp == 8) {
        pg8::Gemm g{CAT, (const bf16*)(ws + WS_WMO + (size_t)l * WMO_SZ), MROWS, DM, DM}; pg8::StaticOrder S; S.init(MROWS, DM, G, bx);
        pg8::EpiResid E{X, modl + 5 * 1024, 1.0f, ALPHA_C}; pg8::gemm_phase<pg8::EpiResid, pg8::StaticOrder, true, true>(lds, g, S, E);
    }
}
__global__ void __launch_bounds__(512, 2) fwd_kernel(Args A) {
    extern __shared__ __attribute__((aligned(16))) unsigned char lds_raw[];
    LAS unsigned char* lds = (LAS unsigned char*)lds_raw;
    cg::grid_group grid = cg::this_grid();
    ArgsP ap0 = (ArgsP)__builtin_amdgcn_kernarg_segment_ptr();
    const int lo = A.ph_lo, hi = A.ph_hi;
    for (int ph = lo; ph < hi; ++ph) {
        run_phase(ap0, lds, ph);
        if (ph + 1 < hi) grid.sync();
    }
}

extern "C" void kernel_launch(void* const* d_in, const int* in_sizes, int n_in, void* d_out, int out_size, void* d_ws, size_t ws_size, hipStream_t stream) {
    static int grid = 0;
    if (grid == 0) {
        if (n_in != 23 || out_size != MROWS * DM || ws_size < WS_END) { fprintf(stderr, "kernel_launch: unexpected shapes (n_in %d out %d ws %zu)\n", n_in, out_size, ws_size); grid = -1; return; }
        int dev = 0, cus = 0, per_cu = 0;
        hipGetDevice(&dev); hipDeviceGetAttribute(&cus, hipDeviceAttributeMultiprocessorCount, dev);
        if (hipFuncSetAttribute((const void*)fwd_kernel, hipFuncAttributeMaxDynamicSharedMemorySize, LDS_BYTES) != hipSuccess) { fprintf(stderr, "kernel_launch: hipFuncSetAttribute failed\n"); grid = -1; return; }
        hipOccupancyMaxActiveBlocksPerMultiprocessor(&per_cu, (const void*)fwd_kernel, 512, LDS_BYTES);
        (void)hipGetLastError();
        if (per_cu < 1) { fprintf(stderr, "kernel_launch: occupancy query says %d blocks per CU\n", per_cu); per_cu = 1; }
        grid = cus;
    }
    if (grid < 0) return;
    hipMemsetAsync((char*)d_ws + WS_CTL, 0, 4096, stream);
    Args a{};
    for (int i = 0; i < 23; ++i) a.in[i] = (const float*)d_in[i];
    a.out = (float*)d_out; a.ws = (unsigned char*)d_ws;
#if MK_PER_PHASE
    for (int ph = 0; ph < NPHASE; ++ph) { a.ph_lo = ph; a.ph_hi = ph + 1; hipLaunchKernelGGL(fwd_kernel, dim3(grid), dim3(512), LDS_BYTES, stream, a); }
#else
    a.ph_lo = 0; a.ph_hi = NPHASE;
    void* args[] = {&a};
    hipError_t e = hipLaunchCooperativeKernel((const void*)fwd_kernel, dim3(grid), dim3(512), args, LDS_BYTES, stream);
    if (e != hipSuccess) fprintf(stderr, "cooperative launch failed: %s (grid %d)\n", hipGetErrorString(e), grid);
#endif
}
```
